# Optimizing an MI355X kernel written in HIP

```python
import jax, jax.numpy as jnp
from jax import lax
import numpy as np

D_MODEL = 2048
BATCH = 2
SEQ = 16384
DEPTH = 1

N_META = 16
D_MIX = 2 * D_MODEL
D_CONV = D_MIX // 2
CONV_GROUPS = 16
SHORT_CONV_W = 3
D_SSM = D_MIX - D_CONV
SSM_HEAD_DIM = 64
SSM_HEADS = D_SSM // SSM_HEAD_DIM
SSM_GROUPS = 8
SSM_HEADS_PER_GROUP = SSM_HEADS // SSM_GROUPS
SSM_STATE = 128
SSM_CONV_W = 4
CHUNK = 128
SSD_FRONT_PAD = CHUNK - N_META
D_XBC = D_SSM + 2 * SSM_GROUPS * SSM_STATE
D_IN_PROJ = 3 * D_CONV + D_SSM + D_XBC + SSM_HEADS
D_FF = 4 * D_MODEL
EPS = 1e-6
DT_MIN = 1e-3
DT_MAX = 1e-1

kernel_name = "hymba_shortconv_ssd_hybrid_layer"


def rms_norm(x, gain):
    xf = x.astype(jnp.float32)
    y = xf * lax.rsqrt(jnp.mean(xf * xf, axis=-1, keepdims=True) + EPS)
    return (y * gain.astype(jnp.float32)).astype(x.dtype)


def grouped_rms_norm(x, gain, n_groups):
    lead = x.shape[:-1]
    d = x.shape[-1]
    xg = x.astype(jnp.float32).reshape(*lead, n_groups, d // n_groups)
    xg = xg * lax.rsqrt(jnp.mean(xg * xg, axis=-1, keepdims=True) + EPS)
    return (xg.reshape(*lead, d) * gain.astype(jnp.float32)).astype(x.dtype)


def causal_depthwise_conv(x, w):
    k_w = w.shape[0]
    length = x.shape[1]
    xp = jnp.pad(x, ((0, 0), (k_w - 1, 0), (0, 0)))
    y = w[k_w - 1] * x
    for k in range(k_w - 1):
        y = y + w[k] * xp[:, k:k + length]
    return y


def pad_front(a, n):
    return jnp.pad(a, [(0, 0), (n, 0)] + [(0, 0)] * (a.ndim - 2))


def segsum_exp(a):
    q = a.shape[-1]
    cs = jnp.cumsum(a, axis=-1)
    diff = cs[..., :, None] - cs[..., None, :]
    mask = jnp.tril(jnp.ones((q, q), dtype=bool))
    return jnp.exp(jnp.where(mask, diff, -jnp.inf))


def ssd_chunked(x_dt, a_dt, b, c):
    bsz, t_len = x_dt.shape[:2]
    nc = t_len // CHUNK
    g, r, p, n = SSM_GROUPS, SSM_HEADS_PER_GROUP, SSM_HEAD_DIM, SSM_STATE
    x = x_dt.reshape(bsz, nc, CHUNK, g, r, p)
    b = b.reshape(bsz, nc, CHUNK, g, n)
    c = c.reshape(bsz, nc, CHUNK, g, n)
    a = a_dt.reshape(bsz, nc, CHUNK, g, r).transpose(0, 3, 4, 1, 2)
    a_cs = jnp.cumsum(a, axis=-1)

    decay_mat = segsum_exp(a)
    cb = jnp.einsum("bclgn,bcsgn->bgcls", c, b)
    scores = cb[:, :, None] * decay_mat
    y_diag = jnp.einsum("bgrcls,bcsgrp->bclgrp", scores, x)

    decay_to_end = jnp.exp(a_cs[..., -1:] - a_cs).transpose(0, 3, 4, 1, 2)
    states = jnp.einsum("bclgn,bclgrp->bcgrpn", b, x * decay_to_end[..., None])

    chunk_decay = jnp.exp(a_cs[..., -1]).transpose(3, 0, 1, 2)

    def step(h, inp):
        dec, s = inp
        return h * dec[..., None, None] + s, h

    h0 = jnp.zeros((bsz, g, r, p, n), states.dtype)
    _, prev_states = lax.scan(step, h0, (chunk_decay, states.transpose(1, 0, 2, 3, 4, 5)))

    decay_from_start = jnp.exp(a_cs).transpose(0, 3, 4, 1, 2)
    y_off = jnp.einsum("bclgn,cbgrpn->bclgrp", c, prev_states) * decay_from_start[..., None]
    return (y_diag + y_off).reshape(bsz, t_len, SSM_HEADS, p)


def hybrid_mixer(h, w_in, short_conv_w, conv_norm_g, ssm_conv_w, ssm_conv_b,
                 dt_bias, a_log, d_skip, ssm_norm_g, w_out):
    bsz, length, _ = h.shape
    proj = h @ w_in
    o1 = D_CONV
    o2 = 2 * D_CONV
    o3 = 3 * D_CONV
    o4 = o3 + D_SSM
    o5 = o4 + D_XBC
    gate_b, gate_c, v, z, xbc, dt_raw = jnp.split(proj, [o1, o2, o3, o4, o5], axis=-1)

    y_conv = gate_b * causal_depthwise_conv(gate_c * v, short_conv_w)
    y_conv = grouped_rms_norm(y_conv, conv_norm_g, CONV_GROUPS)

    xbc = jax.nn.silu(causal_depthwise_conv(xbc, ssm_conv_w) + ssm_conv_b)
    xs, bs, cs = jnp.split(xbc, [D_SSM, D_SSM + SSM_GROUPS * SSM_STATE], axis=-1)
    xs = xs.reshape(bsz, length, SSM_HEADS, SSM_HEAD_DIM)
    bs = bs.reshape(bsz, length, SSM_GROUPS, SSM_STATE)
    cs = cs.reshape(bsz, length, SSM_GROUPS, SSM_STATE)
    dt = jax.nn.softplus(dt_raw.astype(jnp.float32) + dt_bias.astype(jnp.float32))
    a_neg = -jnp.exp(a_log.astype(jnp.float32))
    x_dt = xs * dt[..., None].astype(xs.dtype)
    a_dt = dt * a_neg
    y_ssm = ssd_chunked(pad_front(x_dt, SSD_FRONT_PAD), pad_front(a_dt, SSD_FRONT_PAD),
                        pad_front(bs, SSD_FRONT_PAD), pad_front(cs, SSD_FRONT_PAD))
    y_ssm = y_ssm[:, SSD_FRONT_PAD:].astype(xs.dtype) + d_skip[:, None] * xs
    y_ssm = y_ssm.reshape(bsz, length, D_SSM)
    y_ssm = grouped_rms_norm(y_ssm * jax.nn.silu(z), ssm_norm_g, SSM_GROUPS)

    return jnp.concatenate([y_conv, y_ssm], axis=-1) @ w_out


def squared_relu_mlp(h, w_ff1, w_ff2):
    return jnp.square(jax.nn.relu(h @ w_ff1)) @ w_ff2


def setup_inputs(seed: int = 0) -> dict:
    key = jax.random.key(seed)
    ks = jax.random.split(key, 18)
    f32 = jnp.float32

    def gain(k, d):
        return 1.0 + 0.02 * jax.random.normal(k, (DEPTH, d), f32)

    dt_init = jnp.exp(jax.random.uniform(ks[7], (DEPTH, SSM_HEADS), f32,
                                         minval=np.log(DT_MIN), maxval=np.log(DT_MAX)))
    dt_bias = dt_init + jnp.log(-jnp.expm1(-dt_init))
    return {
        "x": jax.random.normal(ks[0], (BATCH, SEQ, D_MODEL), f32),
        "meta_tokens": jax.random.normal(ks[1], (N_META, D_MODEL), f32),
        "w_in": jax.random.normal(ks[2], (DEPTH, D_MODEL, D_IN_PROJ), f32) * D_MODEL ** -0.5,
        "short_conv_w": jax.random.normal(ks[3], (DEPTH, SHORT_CONV_W, D_CONV), f32) * SHORT_CONV_W ** -0.5,
        "conv_norm_g": gain(ks[4], D_CONV),
        "ssm_conv_w": jax.random.normal(ks[5], (DEPTH, SSM_CONV_W, D_XBC), f32) * SSM_CONV_W ** -0.5,
        "ssm_conv_b": 0.02 * jax.random.normal(ks[6], (DEPTH, D_XBC), f32),
        "dt_bias": dt_bias,
        "a_log": jnp.log(jax.random.uniform(ks[8], (DEPTH, SSM_HEADS), f32, minval=1.0, maxval=16.0)),
        "d_skip": 1.0 + 0.02 * jax.random.normal(ks[9], (DEPTH, SSM_HEADS), f32),
        "ssm_norm_g": gain(ks[10], D_SSM),
        "w_out": jax.random.normal(ks[11], (DEPTH, D_MIX, D_MODEL), f32) * D_MIX ** -0.5,
        "pre_mix_g": gain(ks[12], D_MODEL),
        "post_mix_g": gain(ks[13], D_MODEL),
        "pre_mlp_g": gain(ks[14], D_MODEL),
        "post_mlp_g": gain(ks[15], D_MODEL),
        "w_ff1": jax.random.normal(ks[16], (DEPTH, D_MODEL, D_FF), f32) * D_MODEL ** -0.5,
        "w_ff2": jax.random.normal(ks[17], (DEPTH, D_FF, D_MODEL), f32) * D_FF ** -0.5,
    }


def reference(x, meta_tokens, w_in, short_conv_w, conv_norm_g, ssm_conv_w, ssm_conv_b,
              dt_bias, a_log, d_skip, ssm_norm_g, w_out, pre_mix_g, post_mix_g,
              pre_mlp_g, post_mlp_g, w_ff1, w_ff2):
    in_dtype = x.dtype
    bsz = x.shape[0]
    meta = jnp.broadcast_to(meta_tokens[None].astype(in_dtype), (bsz, N_META, D_MODEL))
    h = jnp.concatenate([meta, x], axis=1)
    for i in range(DEPTH):
        mix = hybrid_mixer(rms_norm(h, pre_mix_g[i]), w_in[i], short_conv_w[i], conv_norm_g[i],
                           ssm_conv_w[i], ssm_conv_b[i], dt_bias[i], a_log[i], d_skip[i],
                           ssm_norm_g[i], w_out[i])
        h = h + rms_norm(mix, post_mix_g[i])
        ff = squared_relu_mlp(rms_norm(h, pre_mlp_g[i]), w_ff1[i], w_ff2[i])
        h = h + rms_norm(ff, post_mlp_g[i])
    return h[:, N_META:].astype(in_dtype)
```

```cpp
#include <hip/hip_runtime.h>
#include <hip/hip_cooperative_groups.h>
#include <cstdio>
namespace cg = cooperative_groups;

#define LAS __attribute__((address_space(3)))
typedef unsigned short bf16_t;
typedef short bf16x8 __attribute__((ext_vector_type(8)));
typedef float f32x4 __attribute__((ext_vector_type(4)));
typedef float f32x2 __attribute__((ext_vector_type(2)));
typedef unsigned u32x4 __attribute__((ext_vector_type(4)));
typedef unsigned u32x2 __attribute__((ext_vector_type(2)));

constexpr int DM = 2048, NBATCH = 2, SEQ = 16384, NMETA = 16;
constexpr int LP = 16512;
constexpr int TP = NBATCH * LP;
constexpr int MR = NBATCH * SEQ;
constexpr int NIN = 12320, LDP = 12544;
constexpr int COL_GB = 0, COL_Z = 2048, COL_GC = 4096, COL_V = 6144, COL_X = 8192, COL_B = 10240, COL_C = 11264, COL_DT = 12288;
constexpr int DFF = 8192, DMIX = 4096;
constexpr float EPS = 1e-6f;
constexpr int LDS_BYTES = 147456;

constexpr size_t WS_WOUT = 0;
constexpr size_t WS_W1 = WS_WOUT + (size_t)DM * DMIX * 2;
constexpr size_t WS_W2 = WS_W1 + (size_t)DFF * DM * 2;
constexpr size_t WS_PROJ = WS_W2 + (size_t)DM * DFF * 2;
constexpr size_t WS_TAIL = WS_PROJ + (size_t)TP * LDP * 2;
constexpr size_t WS_TAIL_BYTES = (size_t)MR * DM * 2;
constexpr size_t WS_DEC = WS_TAIL + WS_TAIL_BYTES;
constexpr size_t WS_END = WS_DEC + (size_t)NBATCH * 128 * 32 * 4;
constexpr size_t WS_HID = WS_PROJ;
constexpr size_t WS_FF = WS_PROJ + (size_t)MR * DFF * 2;

struct Params {
    const float *x, *meta, *w_in, *scw, *cng, *cw, *cb, *dtb, *alog, *dsk, *sng, *w_out, *g_premix, *g_postmix, *g_premlp, *g_postmlp, *w1, *w2;
    float* out; unsigned char* ws;
};

__device__ __forceinline__ unsigned cvt_pk_bf16(float lo, float hi) { unsigned r; asm volatile("v_cvt_pk_bf16_f32 %0, %1, %2" : "=v"(r) : "v"(lo), "v"(hi)); return r; }
__device__ __forceinline__ float bf_lo(unsigned w) { return __uint_as_float(w << 16); }
__device__ __forceinline__ float bf_hi(unsigned w) { return __uint_as_float(w & 0xffff0000u); }
__device__ __forceinline__ float bf2f(bf16_t b) { return __uint_as_float(((unsigned)b) << 16); }
__device__ __forceinline__ float wave_sum(float v) {
#pragma unroll
    for (int o = 1; o < 64; o <<= 1) v += __shfl_xor(v, o);
    return v;
}
__device__ __forceinline__ float silu_f(float v) { return v * __builtin_amdgcn_rcpf(1.0f + __expf(-v)); }
__device__ __forceinline__ float softplus_f(float v) { return fmaxf(v, 0.f) + log1pf(__expf(-fabsf(v))); }

namespace pg8 {
constexpr int BM = 256, BK = 64, HALF = 128, HTB = HALF * BK * 2, STAGE_BYTES = 8 * HTB, NXCD = 8, WGM = 8;
__host__ __device__ __forceinline__ int lds_byte(int r, int c) { const int st = (r >> 4) * 2 + (c >> 5), rr = r & 15, cc = c & 31, ob = rr * 64 + cc * 2; return st * 1024 + (ob ^ (((ob >> 9) & 1) << 5)); }
__host__ __device__ __forceinline__ void stage_rc(int b, int& R, int& C) { const int st = b / 1024, sb = b % 1024, swz = sb ^ (((sb >> 9) & 1) << 5); R = (st >> 1) * 16 + swz / 64; C = (st & 1) * 32 + (swz % 64) / 2; }
__host__ __device__ __forceinline__ int perm32(int rho) { const int n = rho >> 4, i = rho & 15; return 8 * (i >> 2) + 4 * n + (i & 3); }

struct Unit { int pm, pn; };
struct Gemm { const bf16_t* A; const bf16_t* Bt; int nM, nN, K, lda, amode; };

struct StaticOrder {
    int nM, nN, nwg, G, c;
    __device__ void init(int nM_, int nN_, int G_, int c_) { nM = nM_; nN = nN_; nwg = nM * nN; G = G_; c = c_; }
    __device__ bool next(int i, Unit& u) const {
        const long L = (long)i * G + c; if (L >= nwg) return false;
        int wgid = (int)L; { const int q = nwg / NXCD, r = nwg % NXCD, xcd = wgid % NXCD, off = wgid / NXCD; wgid = (xcd < r ? xcd * (q + 1) : r * (q + 1) + (xcd - r) * q) + off; }
        const int nig = WGM * nN, gid = wgid / nig, fm = gid * WGM, gsz = (nM - fm) < WGM ? (nM - fm) : WGM;
        u.pm = fm + ((wgid % nig) % gsz); u.pn = (wgid % nig) / gsz; return true;
    }
};

struct EpiF32 {
    static constexpr bool PERM = false;
    float* C; int ldc;
    __device__ __forceinline__ void operator()(const f32x4 (&acc)[2][2][4][2], const Unit& u, int wr, int wc, int fr, int fq) const {
        const int row0 = u.pm * BM + wr * 64 + fr, col0 = u.pn * BM + wc * 32 + 4 * fq;
#pragma unroll
        for (int ai = 0; ai < 2; ++ai)
#pragma unroll
            for (int m = 0; m < 4; ++m) { float* rowp = C + (size_t)(row0 + ai * HALF + m * 16) * ldc + col0;
#pragma unroll
                for (int bj = 0; bj < 2; ++bj)
#pragma unroll
                    for (int n = 0; n < 2; ++n) *(f32x4*)(rowp + bj * HALF + n * 16) = acc[ai][bj][m][n]; }
    }
};
template <int ACT  > struct EpiBf16 {
    static constexpr bool PERM = true;
    bf16_t* O; int ldc;
    __device__ __forceinline__ void operator()(const f32x4 (&acc)[2][2][4][2], const Unit& u, int wr, int wc, int fr, int fq) const {
        const int row0 = u.pm * BM + wr * 64 + fr; const int col0 = u.pn * BM + wc * 32 + 8 * fq;
#pragma unroll
        for (int ai = 0; ai < 2; ++ai)
#pragma unroll
            for (int m = 0; m < 4; ++m) { bf16_t* rowp = O + (size_t)(row0 + ai * HALF + m * 16) * ldc + col0;
#pragma unroll
                for (int bj = 0; bj < 2; ++bj) { f32x4 v0 = acc[ai][bj][m][0], v1 = acc[ai][bj][m][1];
                    if (ACT == 1) {
#pragma unroll
                        for (int j = 0; j < 4; ++j) { const float a = fmaxf(v0[j], 0.f), b = fmaxf(v1[j], 0.f); v0[j] = a * a; v1[j] = b * b; } }
                    u32x4 w; w.x = cvt_pk_bf16(v0[0], v0[1]); w.y = cvt_pk_bf16(v0[2], v0[3]); w.z = cvt_pk_bf16(v1[0], v1[1]); w.w = cvt_pk_bf16(v1[2], v1[3]);
                    *(u32x4*)(rowp + bj * HALF) = w; } }
    }
};

template <class Epi>
__device__ __forceinline__ void gemm_phase(LAS unsigned char* lds, const Gemm g, const StaticOrder& S, const Epi& E) {
    const int tid = threadIdx.x, wid = __builtin_amdgcn_readfirstlane(tid >> 6), lane = tid & 63, wr = wid >> 2, wc = wid & 3, fr = lane & 15, fq = lane >> 4;
    const int K = g.K, nt = K / BK, lda = g.lda;
    unsigned voffA[2], voffB[2];
#pragma unroll
    for (int i = 0; i < 2; ++i) { int R, C; stage_rc(tid * 16 + i * 8192, R, C); const int Rb = Epi::PERM ? ((R & ~31) + perm32(R & 31)) : R;
        voffA[i] = (unsigned)(R * lda + C) * 2u; voffB[i] = (unsigned)(Rb * K + C) * 2u; }
    const size_t kstep = (size_t)(BK * 2);
    const size_t hstepA = (size_t)HALF * lda * 2, hstepB = (size_t)HALF * K * 2;
    const unsigned ldsw = (unsigned)wid * 1024u;
    const int aoff = lds_byte(wr * 64 + fr, fq * 8), boff = lds_byte(wc * 32 + fr, fq * 8);
#define PG8_SA(b, h) (((b) * 2 + (h)) * HTB)
#define PG8_SB(b, h) ((4 + (b) * 2 + (h)) * HTB)
#define PG8_STAGE(bufoff, gbase, voff) do { _Pragma("unroll") for (int _i = 0; _i < 2; ++_i) \
        __builtin_amdgcn_global_load_lds((const unsigned*)((const char*)(gbase) + (voff)[_i]), (LAS unsigned*)(lds + (bufoff) + ldsw + _i * 8192), 16, 0, 0); } while (0)
#define PG8_LDA(dst, b, h) do { _Pragma("unroll") for (int m = 0; m < 4; ++m) _Pragma("unroll") for (int k = 0; k < 2; ++k) dst[m][k] = *(const LAS bf16x8*)(lds + PG8_SA(b, h) + aoff + m * 2048 + k * 1024); } while (0)
#define PG8_LDB(dst, b, h) do { _Pragma("unroll") for (int n = 0; n < 2; ++n) _Pragma("unroll") for (int k = 0; k < 2; ++k) dst[n][k] = *(const LAS bf16x8*)(lds + PG8_SB(b, h) + boff + n * 2048 + k * 1024); } while (0)
#define PG8_MMA(ai, bj, At, Bt) do { __builtin_amdgcn_s_setprio(1); _Pragma("unroll") for (int m = 0; m < 4; ++m) _Pragma("unroll") for (int n = 0; n < 2; ++n) _Pragma("unroll") for (int k = 0; k < 2; ++k) \
        acc[ai][bj][m][n] = __builtin_amdgcn_mfma_f32_16x16x32_bf16(Bt[n][k], At[m][k], acc[ai][bj][m][n], 0, 0, 0); __builtin_amdgcn_s_setprio(0); } while (0)
#define PG8_WAIT_V(n) asm volatile("s_waitcnt vmcnt(" #n ")" ::: "memory")
#define PG8_WAIT_L(n) asm volatile("s_waitcnt lgkmcnt(" #n ")" ::: "memory")
#define PG8_BAR __builtin_amdgcn_s_barrier()
#define PG8_SCHED __builtin_amdgcn_sched_barrier(0)
#define PG8_AROW(pm) ((size_t)((pm) * BM + (g.amode ? 128 + 128 * ((pm) >> 6) : 0)))
    Unit cur, nxt; int ui = 0;
    if (!S.next(0, cur)) return;
    f32x4 acc[2][2][4][2];
#pragma unroll
    for (int a = 0; a < 2; ++a)
#pragma unroll
        for (int b = 0; b < 2; ++b)
#pragma unroll
            for (int m = 0; m < 4; ++m)
#pragma unroll
                for (int n = 0; n < 2; ++n) acc[a][b][m][n] = (f32x4){0.f, 0.f, 0.f, 0.f};
    bf16x8 At[4][2], B0[2][2], B1[2][2];
    const char* cA = (const char*)g.A + PG8_AROW(cur.pm) * lda * 2; const char* cB = (const char*)g.Bt + (size_t)cur.pn * BM * K * 2;
    PG8_STAGE(PG8_SB(0, 0), cB, voffB); PG8_STAGE(PG8_SA(0, 0), cA, voffA); PG8_STAGE(PG8_SB(0, 1), cB + hstepB, voffB); PG8_STAGE(PG8_SA(0, 1), cA + hstepA, voffA);
    if (wr == 1) PG8_BAR;
    PG8_WAIT_V(4); PG8_BAR;
    PG8_STAGE(PG8_SB(1, 0), cB + kstep, voffB); PG8_STAGE(PG8_SA(1, 0), cA + kstep, voffA); PG8_STAGE(PG8_SB(1, 1), cB + hstepB + kstep, voffB);
    PG8_WAIT_V(6); PG8_BAR;
    for (;;) {
        const bool has_next = S.next(ui + 1, nxt);
        const char* nA = has_next ? (const char*)g.A + PG8_AROW(nxt.pm) * lda * 2 : cA; const char* nB = has_next ? (const char*)g.Bt + (size_t)nxt.pn * BM * K * 2 : cB;
        for (int t = 0; t < nt; t += 2) {
            const bool last = (t == nt - 2);
            const char* a1 = cA + (size_t)(t + 1) * kstep;
            const char* a2 = last ? nA : cA + (size_t)(t + 2) * kstep; const char* b2 = last ? nB : cB + (size_t)(t + 2) * kstep;
            const char* a3 = a2 + kstep; const char* b3 = b2 + kstep;
            PG8_LDB(B0, 0, 0); PG8_SCHED; PG8_LDA(At, 0, 0); PG8_STAGE(PG8_SA(1, 1), a1 + hstepA, voffA);
            PG8_WAIT_L(8); PG8_BAR; PG8_WAIT_L(0); PG8_MMA(0, 0, At, B0); PG8_BAR; PG8_SCHED;
            PG8_LDB(B1, 0, 1); PG8_STAGE(PG8_SB(0, 0), b2, voffB);
            PG8_BAR; PG8_WAIT_L(0); PG8_MMA(0, 1, At, B1); PG8_BAR;
            PG8_LDA(At, 0, 1); PG8_STAGE(PG8_SA(0, 0), a2, voffA);
            PG8_BAR; PG8_WAIT_L(0); PG8_MMA(1, 0, At, B0); PG8_BAR; PG8_SCHED;
            PG8_STAGE(PG8_SB(0, 1), b2 + hstepB, voffB);
            PG8_WAIT_V(6); PG8_BAR; PG8_MMA(1, 1, At, B1); PG8_BAR;
            PG8_LDB(B0, 1, 0); PG8_SCHED; PG8_LDA(At, 1, 0); PG8_STAGE(PG8_SA(0, 1), a2 + hstepA, voffA);
            PG8_WAIT_L(8); PG8_BAR; PG8_WAIT_L(0); PG8_MMA(0, 0, At, B0); PG8_BAR; PG8_SCHED;
            PG8_LDB(B1, 1, 1); PG8_STAGE(PG8_SB(1, 0), b3, voffB);
            PG8_BAR; PG8_WAIT_L(0); PG8_MMA(0, 1, At, B1); PG8_BAR;
            PG8_LDA(At, 1, 1); PG8_STAGE(PG8_SA(1, 0), a3, voffA);
            PG8_BAR; PG8_WAIT_L(0); PG8_MMA(1, 0, At, B0); PG8_BAR; PG8_SCHED;
            PG8_STAGE(PG8_SB(1, 1), b3 + hstepB, voffB);
            PG8_WAIT_V(6); PG8_BAR; PG8_MMA(1, 1, At, B1); PG8_BAR;
        }
        E(acc, cur, wr, wc, fr, fq);
        if (!has_next) break;
#pragma unroll
        for (int a = 0; a < 2; ++a)
#pragma unroll
            for (int b = 0; b < 2; ++b)
#pragma unroll
                for (int m = 0; m < 4; ++m)
#pragma unroll
                    for (int n = 0; n < 2; ++n) acc[a][b][m][n] = (f32x4){0.f, 0.f, 0.f, 0.f};
        cur = nxt; cA = nA; cB = nB; ++ui;
    }
    PG8_WAIT_V(0);
    if (wr == 0) PG8_BAR;
    PG8_BAR;
#undef PG8_SA
#undef PG8_SB
#undef PG8_STAGE
#undef PG8_LDA
#undef PG8_LDB
#undef PG8_MMA
#undef PG8_WAIT_V
#undef PG8_WAIT_L
#undef PG8_BAR
#undef PG8_SCHED
#undef PG8_AROW
}
}

__device__ __forceinline__ void p0_transpose_item(const float* W, int K, int N, bf16_t* WT, int drow0, int scol0, int k0, LAS float* scr, int lane) {
    if (scol0 >= 0) {
#pragma unroll 8
        for (int i = 0; i < 32; ++i) { const int kk = 2 * i + (lane >> 5); scr[kk * 33 + (lane & 31)] = W[(size_t)(k0 + kk) * N + scol0 + (lane & 31)]; }
    } else {
#pragma unroll 8
        for (int i = 0; i < 32; ++i) { const int kk = 2 * i + (lane >> 5); scr[kk * 33 + (lane & 31)] = 0.f; }
    }
    asm volatile("s_waitcnt lgkmcnt(0)" ::: "memory");
    const int c = lane & 7;
#pragma unroll
    for (int j = 0; j < 4; ++j) { const int n = (lane >> 3) + 8 * j; const LAS float* s = scr + (8 * c) * 33 + n;
        u32x4 o; o.x = cvt_pk_bf16(s[0 * 33], s[1 * 33]); o.y = cvt_pk_bf16(s[2 * 33], s[3 * 33]); o.z = cvt_pk_bf16(s[4 * 33], s[5 * 33]); o.w = cvt_pk_bf16(s[6 * 33], s[7 * 33]);
        *(u32x4*)(WT + (size_t)(drow0 + n) * K + k0 + 8 * c) = o; }
    asm volatile("s_waitcnt lgkmcnt(0)" ::: "memory");
}
__device__ __forceinline__ int win_src_col(int n) {
    if (n < 2048) return n;
    if (n < 4096) return 6144 + (n - 2048);
    if (n < 6144) return 2048 + (n - 4096);
    if (n < 8192) return 4096 + (n - 6144);
    if (n < NIN) return n;
    return -1;
}
__device__ __forceinline__ void phase0(const Params& P, LAS unsigned char* lds) {
    const int tid = threadIdx.x, lane = tid & 63, wave = tid >> 6;
    LAS float* scr = (LAS float*)(lds + wave * 16384);
    const int gw = blockIdx.x * 8 + wave, NGW = gridDim.x * 8;
    bf16_t* WinT = (bf16_t*)(P.ws + WS_TAIL); bf16_t* WoutT = (bf16_t*)(P.ws + WS_WOUT); bf16_t* W1T = (bf16_t*)(P.ws + WS_W1); bf16_t* W2T = (bf16_t*)(P.ws + WS_W2);
    constexpr int I_IN = (DM / 64) * (LDP / 32), I_OUT = (DMIX / 64) * (DM / 32), I_1 = (DM / 64) * (DFF / 32), I_2 = (DFF / 64) * (DM / 32);
    for (int it = gw; it < I_IN + I_OUT + I_1 + I_2; it += NGW) {
        int r = it;
        if (r < I_IN) { const int nb = r % (LDP / 32), kb = r / (LDP / 32); p0_transpose_item(P.w_in, DM, NIN, WinT, nb * 32, win_src_col(nb * 32), kb * 64, scr, lane); continue; } r -= I_IN;
        if (r < I_OUT) { const int nb = r % (DM / 32), kb = r / (DM / 32); p0_transpose_item(P.w_out, DMIX, DM, WoutT, nb * 32, nb * 32, kb * 64, scr, lane); continue; } r -= I_OUT;
        if (r < I_1) { const int nb = r % (DFF / 32), kb = r / (DFF / 32); p0_transpose_item(P.w1, DM, DFF, W1T, nb * 32, nb * 32, kb * 64, scr, lane); continue; } r -= I_1;
        { const int nb = r % (DM / 32), kb = r / (DM / 32); p0_transpose_item(P.w2, DFF, DM, W2T, nb * 32, nb * 32, kb * 64, scr, lane); }
    }
    bf16_t* HN = (bf16_t*)P.out;
    for (int r = gw; r < TP; r += NGW) {
        const int b = r / LP, p = r % LP;
        u32x2* o8 = (u32x2*)(HN + (size_t)r * DM) + lane;
        if (p < 112) {
#pragma unroll
            for (int j = 0; j < 8; ++j) o8[64 * j] = (u32x2){0u, 0u};
            continue;
        }
        const float* src = (p < 128) ? P.meta + (size_t)(p - 112) * DM : P.x + ((size_t)b * SEQ + (p - 128)) * DM;
        const f32x4* xr = (const f32x4*)src + lane; const f32x4* gr = (const f32x4*)P.g_premix + lane;
        f32x4 v[8]; float s = 0.f;
#pragma unroll
        for (int j = 0; j < 8; ++j) { v[j] = xr[64 * j]; s += (v[j].x * v[j].x + v[j].y * v[j].y) + (v[j].z * v[j].z + v[j].w * v[j].w); }
        const float rs = rsqrtf(wave_sum(s) * (1.f / DM) + EPS);
#pragma unroll
        for (int j = 0; j < 8; ++j) { const f32x4 gg = gr[64 * j]; o8[64 * j] = (u32x2){cvt_pk_bf16(v[j].x * rs * gg.x, v[j].y * rs * gg.y), cvt_pk_bf16(v[j].z * rs * gg.z, v[j].w * rs * gg.w)}; }
    }
}

constexpr int LROW = 272;
constexpr int L_CS = 0, L_DT = 2048, L_WG = 4096, L_TOT = 6144, L_X = 8192, L_B = L_X + 256 * LROW, L_P0 = L_B + 128 * LROW, L_P1 = L_P0 + 64 * LROW;
static_assert(L_P1 + 64 * LROW <= LDS_BYTES, "lds");

__device__ __forceinline__ void ssd_dt_prologue(const Params& P, LAS unsigned char* lds, const bf16_t* proj, size_t R0, int g) {
    const int tid = threadIdx.x, lane = tid & 63, wid = tid >> 6, hh = tid >> 7, l = tid & 127, head = 4 * g + hh;
    LAS float* cs = (LAS float*)(lds + L_CS); LAS float* dt = (LAS float*)(lds + L_DT); LAS float* tot = (LAS float*)(lds + L_TOT);
    const float raw = bf2f(proj[(R0 + l) * LDP + COL_DT + head]);
    const float dtv = softplus_f(raw + P.dtb[head]);
    float s = -__expf(P.alog[head]) * dtv;
#pragma unroll
    for (int o = 1; o < 64; o <<= 1) { const float t = __shfl_up(s, o); if (lane >= o) s += t; }
    if (lane == 63) tot[wid] = s;
    __syncthreads();
    if (wid & 1) s += tot[wid - 1];
    cs[hh * 128 + l] = s; dt[hh * 128 + l] = dtv;
    __syncthreads();
}

template <bool SCALE>
__device__ __forceinline__ void ssd_conv_x(const Params& P, LAS unsigned char* lds, const bf16_t* proj, size_t R0, int c, int g) {
    const int tid = threadIdx.x, cp = tid & 127, run = tid >> 7, ch = 2 * cp, hh = cp >> 5;
    const int xc = 256 * g + ch;
    const bf16_t* src = proj + COL_X + xc;
    float w0[4], w1[4];
#pragma unroll
    for (int k = 0; k < 4; ++k) { w0[k] = P.cw[k * 4096 + xc]; w1[k] = P.cw[k * 4096 + xc + 1]; }
    const float b0 = P.cb[xc], b1 = P.cb[xc + 1];
    const LAS float* wg = (const LAS float*)(lds + L_WG) + hh * 128;
    const int l0 = 32 * run;
    float p0[3], p1[3];
#pragma unroll
    for (int k = 0; k < 3; ++k) { const int li = l0 - 3 + k; unsigned w = 0u; if (c > 0 || li >= 0) w = *(const unsigned*)(src + (size_t)((long)R0 + li) * LDP); p0[k] = bf_lo(w); p1[k] = bf_hi(w); }
    for (int i = 0; i < 32; i += 8) {
        unsigned wv[8];
#pragma unroll
        for (int j = 0; j < 8; ++j) wv[j] = *(const unsigned*)(src + (R0 + l0 + i + j) * LDP);
        float o0[8], o1[8];
#pragma unroll
        for (int j = 0; j < 8; ++j) {
            const float c0 = bf_lo(wv[j]), c1 = bf_hi(wv[j]);
            float y0 = b0 + w0[0] * p0[0] + w0[1] * p0[1] + w0[2] * p0[2] + w0[3] * c0;
            float y1 = b1 + w1[0] * p1[0] + w1[1] * p1[1] + w1[2] * p1[2] + w1[3] * c1;
            y0 = silu_f(y0); y1 = silu_f(y1);
            if (SCALE) { const float sc = wg[l0 + i + j]; y0 *= sc; y1 *= sc; }
            o0[j] = y0; o1[j] = y1;
            p0[0] = p0[1]; p0[1] = p0[2]; p0[2] = c0; p1[0] = p1[1]; p1[1] = p1[2]; p1[2] = c1;
        }
        u32x4 q0, q1;
        q0.x = cvt_pk_bf16(o0[0], o0[1]); q0.y = cvt_pk_bf16(o0[2], o0[3]); q0.z = cvt_pk_bf16(o0[4], o0[5]); q0.w = cvt_pk_bf16(o0[6], o0[7]);
        q1.x = cvt_pk_bf16(o1[0], o1[1]); q1.y = cvt_pk_bf16(o1[2], o1[3]); q1.z = cvt_pk_bf16(o1[4], o1[5]); q1.w = cvt_pk_bf16(o1[6], o1[7]);
        *(LAS u32x4*)(lds + L_X + ch * LROW + (l0 + i) * 2) = q0;
        *(LAS u32x4*)(lds + L_X + (ch + 1) * LROW + (l0 + i) * 2) = q1;
    }
}

__device__ __forceinline__ void ssd_states_unit(const Params& P, LAS unsigned char* lds, int unit) {
    const int g = unit & 7, c = (unit >> 3) & 127, b = unit >> 10;
    const int tid = threadIdx.x, lane = tid & 63, wid = tid >> 6, fr = lane & 15, fq = lane >> 4;
    const bf16_t* proj = (const bf16_t*)(P.ws + WS_PROJ);
    const size_t R0 = (size_t)b * LP + (size_t)c * 128;
    ssd_dt_prologue(P, lds, proj, R0, g);
    {
        const int hh = tid >> 7, l = tid & 127;
        const LAS float* cs = (const LAS float*)(lds + L_CS) + hh * 128; const LAS float* dt = (const LAS float*)(lds + L_DT) + hh * 128;
        const float ce = cs[127];
        float w = dt[l] * __expf(ce - cs[l]);
        if (c == 0 && l < 112) w = 0.f;
        ((LAS float*)(lds + L_WG))[hh * 128 + l] = w;
        if (l == 127) ((float*)(P.ws + WS_DEC))[(b * 128 + c) * 32 + 4 * g + hh] = __expf(ce);
    }
    __syncthreads();
    ssd_conv_x<true>(P, lds, proj, R0, c, g);
    {
        const int cp = tid & 63, run = tid >> 6, n0 = 2 * cp, bc = 2048 + 128 * g + n0;
        const bf16_t* src = proj + COL_B + 128 * g + n0;
        float w0[4], w1[4];
#pragma unroll
        for (int k = 0; k < 4; ++k) { w0[k] = P.cw[k * 4096 + bc]; w1[k] = P.cw[k * 4096 + bc + 1]; }
        const float b0 = P.cb[bc], b1 = P.cb[bc + 1];
        const int l0 = 16 * run;
        float p0[3], p1[3];
#pragma unroll
        for (int k = 0; k < 3; ++k) { const int li = l0 - 3 + k; unsigned w = 0u; if (c > 0 || li >= 0) w = *(const unsigned*)(src + (size_t)((long)R0 + li) * LDP); p0[k] = bf_lo(w); p1[k] = bf_hi(w); }
#pragma unroll
        for (int i = 0; i < 16; i += 8) {
            unsigned wv[8];
#pragma unroll
            for (int j = 0; j < 8; ++j) wv[j] = *(const unsigned*)(src + (R0 + l0 + i + j) * LDP);
            float o0[8], o1[8];
#pragma unroll
            for (int j = 0; j < 8; ++j) {
                const float c0 = bf_lo(wv[j]), c1 = bf_hi(wv[j]);
                o0[j] = silu_f(b0 + w0[0] * p0[0] + w0[1] * p0[1] + w0[2] * p0[2] + w0[3] * c0);
                o1[j] = silu_f(b1 + w1[0] * p1[0] + w1[1] * p1[1] + w1[2] * p1[2] + w1[3] * c1);
                p0[0] = p0[1]; p0[1] = p0[2]; p0[2] = c0; p1[0] = p1[1]; p1[1] = p1[2]; p1[2] = c1;
            }
            u32x4 q0, q1;
            q0.x = cvt_pk_bf16(o0[0], o0[1]); q0.y = cvt_pk_bf16(o0[2], o0[3]); q0.z = cvt_pk_bf16(o0[4], o0[5]); q0.w = cvt_pk_bf16(o0[6], o0[7]);
            q1.x = cvt_pk_bf16(o1[0], o1[1]); q1.y = cvt_pk_bf16(o1[2], o1[3]); q1.z = cvt_pk_bf16(o1[4], o1[5]); q1.w = cvt_pk_bf16(o1[6], o1[7]);
            *(LAS u32x4*)(lds + L_B + n0 * LROW + (l0 + i) * 2) = q0;
            *(LAS u32x4*)(lds + L_B + (n0 + 1) * LROW + (l0 + i) * 2) = q1;
        }
    }
    __syncthreads();
    f32x4 acc[2][8];
#pragma unroll
    for (int i = 0; i < 2; ++i)
#pragma unroll
        for (int nt = 0; nt < 8; ++nt) acc[i][nt] = (f32x4){0.f, 0.f, 0.f, 0.f};
#pragma unroll
    for (int ks = 0; ks < 4; ++ks) {
        bf16x8 xf[2];
#pragma unroll
        for (int i = 0; i < 2; ++i) xf[i] = *(const LAS bf16x8*)(lds + L_X + (16 * (2 * wid + i) + fr) * LROW + (32 * ks + 8 * fq) * 2);
#pragma unroll
        for (int nt = 0; nt < 8; ++nt) {
            const bf16x8 bfr = *(const LAS bf16x8*)(lds + L_B + (16 * nt + fr) * LROW + (32 * ks + 8 * fq) * 2);
#pragma unroll
            for (int i = 0; i < 2; ++i) acc[i][nt] = __builtin_amdgcn_mfma_f32_16x16x32_bf16(bfr, xf[i], acc[i][nt], 0, 0, 0);
        }
    }
    float* Sg = (float*)P.out + ((size_t)(b * 128 + c) * 32 + 4 * g + (wid >> 1)) * 8192;
#pragma unroll
    for (int i = 0; i < 2; ++i) { const int pp = (16 * (2 * wid + i) + fr) & 63;
#pragma unroll
        for (int nt = 0; nt < 8; ++nt) *(f32x4*)(Sg + pp * 128 + 16 * nt + 4 * fq) = acc[i][nt]; }
    __syncthreads();
}

__device__ __forceinline__ void shortconv_task(const Params& P, int task, int lane) {
    bf16_t* proj = (bf16_t*)(P.ws + WS_PROJ);
    const int q = task & 3, run = task >> 2, m0 = run * 32;
    const size_t row0 = (size_t)m0 + 128 + 128 * (m0 >> 14);
    const int ch0 = 512 * q + 8 * lane;
    float w[3][8], gn[8];
#pragma unroll
    for (int k = 0; k < 3; ++k) { const f32x4 a = *(const f32x4*)(P.scw + k * 2048 + ch0), bq = *(const f32x4*)(P.scw + k * 2048 + ch0 + 4);
        w[k][0] = a.x; w[k][1] = a.y; w[k][2] = a.z; w[k][3] = a.w; w[k][4] = bq.x; w[k][5] = bq.y; w[k][6] = bq.z; w[k][7] = bq.w; }
    { const f32x4 a = *(const f32x4*)(P.cng + ch0), bq = *(const f32x4*)(P.cng + ch0 + 4); gn[0] = a.x; gn[1] = a.y; gn[2] = a.z; gn[3] = a.w; gn[4] = bq.x; gn[5] = bq.y; gn[6] = bq.z; gn[7] = bq.w; }
    float u1[8], u2[8];
#pragma unroll
    for (int k = 0; k < 2; ++k) {
        const size_t r = row0 - 2 + k;
        const u32x4 cc = *(const u32x4*)(proj + r * LDP + COL_GC + ch0), vv = *(const u32x4*)(proj + r * LDP + COL_V + ch0);
        float* dst = (k == 0) ? u2 : u1;
        dst[0] = bf_lo(cc.x) * bf_lo(vv.x); dst[1] = bf_hi(cc.x) * bf_hi(vv.x); dst[2] = bf_lo(cc.y) * bf_lo(vv.y); dst[3] = bf_hi(cc.y) * bf_hi(vv.y);
        dst[4] = bf_lo(cc.z) * bf_lo(vv.z); dst[5] = bf_hi(cc.z) * bf_hi(vv.z); dst[6] = bf_lo(cc.w) * bf_lo(vv.w); dst[7] = bf_hi(cc.w) * bf_hi(vv.w);
    }
#pragma unroll 4
    for (int t = 0; t < 32; ++t) {
        const size_t r = row0 + t;
        const u32x4 cc = *(const u32x4*)(proj + r * LDP + COL_GC + ch0), vv = *(const u32x4*)(proj + r * LDP + COL_V + ch0), gb = *(const u32x4*)(proj + r * LDP + COL_GB + ch0);
        float u0[8], gbf[8], y[8];
        u0[0] = bf_lo(cc.x) * bf_lo(vv.x); u0[1] = bf_hi(cc.x) * bf_hi(vv.x); u0[2] = bf_lo(cc.y) * bf_lo(vv.y); u0[3] = bf_hi(cc.y) * bf_hi(vv.y);
        u0[4] = bf_lo(cc.z) * bf_lo(vv.z); u0[5] = bf_hi(cc.z) * bf_hi(vv.z); u0[6] = bf_lo(cc.w) * bf_lo(vv.w); u0[7] = bf_hi(cc.w) * bf_hi(vv.w);
        gbf[0] = bf_lo(gb.x); gbf[1] = bf_hi(gb.x); gbf[2] = bf_lo(gb.y); gbf[3] = bf_hi(gb.y); gbf[4] = bf_lo(gb.z); gbf[5] = bf_hi(gb.z); gbf[6] = bf_lo(gb.w); gbf[7] = bf_hi(gb.w);
        float ss = 0.f;
#pragma unroll
        for (int j = 0; j < 8; ++j) { y[j] = gbf[j] * (w[2][j] * u0[j] + w[1][j] * u1[j] + w[0][j] * u2[j]); ss += y[j] * y[j]; u2[j] = u1[j]; u1[j] = u0[j]; }
        ss += __shfl_xor(ss, 1); ss += __shfl_xor(ss, 2); ss += __shfl_xor(ss, 4); ss += __shfl_xor(ss, 8);
        const float rs = rsqrtf(ss * (1.f / 128.f) + EPS);
        u32x4 o; o.x = cvt_pk_bf16(y[0] * rs * gn[0], y[1] * rs * gn[1]); o.y = cvt_pk_bf16(y[2] * rs * gn[2], y[3] * rs * gn[3]);
        o.z = cvt_pk_bf16(y[4] * rs * gn[4], y[5] * rs * gn[5]); o.w = cvt_pk_bf16(y[6] * rs * gn[6], y[7] * rs * gn[7]);
        *(u32x4*)(proj + r * LDP + COL_GB + ch0) = o;
    }
}

__device__ __forceinline__ void scan_phase(const Params& P) {
    const float* S = (const float*)P.out; const float* dec = (const float*)(P.ws + WS_DEC); bf16_t* prev = (bf16_t*)(P.ws + WS_TAIL);
    for (int gid = blockIdx.x * 512 + threadIdx.x; gid < NBATCH * 32 * 64 * 32; gid += gridDim.x * 512) {
        const int n4 = gid & 31, p = (gid >> 5) & 63, h = (gid >> 11) & 31, b = gid >> 16;
        f32x4 st = (f32x4){0.f, 0.f, 0.f, 0.f};
        size_t idx = ((size_t)(b * 128) * 32 + h) * 8192 + p * 128 + 4 * n4;
        const float* dp = dec + (b * 128) * 32 + h;
#pragma unroll 8
        for (int c = 0; c < 128; ++c) {
            const f32x4 sv = *(const f32x4*)(S + idx); const float d = dp[c * 32];
            st = st * d + sv;
            *(u32x2*)(prev + idx) = (u32x2){cvt_pk_bf16(st.x, st.y), cvt_pk_bf16(st.z, st.w)};
            idx += (size_t)32 * 8192;
        }
    }
}

__device__ __forceinline__ void ssd_out_unit(const Params& P, LAS unsigned char* lds, int unit) {
    const int g = unit & 7, c = ((unit >> 3) & 127) + 1, b = unit >> 10;
    const int tid = threadIdx.x, lane = tid & 63, wid = tid >> 6, fr = lane & 15, fq = lane >> 4;
    bf16_t* proj = (bf16_t*)(P.ws + WS_PROJ);
    const size_t R0 = (size_t)b * LP + (size_t)c * 128;
    const bf16_t* prevg = (const bf16_t*)(P.ws + WS_TAIL) + ((size_t)(b * 128 + (c - 1)) * 32 + 4 * g) * 8192;
    u32x4 pf[2];
#pragma unroll
    for (int i = 0; i < 2; ++i) pf[i] = *(const u32x4*)(prevg + (size_t)(tid + 512 * i) * 8);
    ssd_dt_prologue(P, lds, proj, R0, g);
    ssd_conv_x<false>(P, lds, proj, R0, c, g);
    {
        const int c8 = tid & 15, run = tid >> 4, n0 = 8 * c8, bc = 2048 + 128 * g + n0, l0 = 4 * run;
        const bf16_t* src = proj + COL_B + 128 * g + n0;
        float w[4][8], bb[8];
#pragma unroll
        for (int k = 0; k < 4; ++k) { const f32x4 a = *(const f32x4*)(P.cw + k * 4096 + bc), a2 = *(const f32x4*)(P.cw + k * 4096 + bc + 4);
            w[k][0] = a.x; w[k][1] = a.y; w[k][2] = a.z; w[k][3] = a.w; w[k][4] = a2.x; w[k][5] = a2.y; w[k][6] = a2.z; w[k][7] = a2.w; }
        { const f32x4 a = *(const f32x4*)(P.cb + bc), a2 = *(const f32x4*)(P.cb + bc + 4); bb[0] = a.x; bb[1] = a.y; bb[2] = a.z; bb[3] = a.w; bb[4] = a2.x; bb[5] = a2.y; bb[6] = a2.z; bb[7] = a2.w; }
        u32x4 rw[7];
#pragma unroll
        for (int k = 0; k < 7; ++k) rw[k] = *(const u32x4*)(src + (R0 + l0 - 3 + k) * LDP);
#pragma unroll
        for (int t = 0; t < 4; ++t) {
            float y[8];
#pragma unroll
            for (int j = 0; j < 8; ++j) y[j] = bb[j];
#pragma unroll
            for (int k = 0; k < 4; ++k) { const u32x4 q = rw[t + k];
                y[0] += w[k][0] * bf_lo(q.x); y[1] += w[k][1] * bf_hi(q.x); y[2] += w[k][2] * bf_lo(q.y); y[3] += w[k][3] * bf_hi(q.y);
                y[4] += w[k][4] * bf_lo(q.z); y[5] += w[k][5] * bf_hi(q.z); y[6] += w[k][6] * bf_lo(q.w); y[7] += w[k][7] * bf_hi(q.w); }
#pragma unroll
            for (int j = 0; j < 8; ++j) y[j] = silu_f(y[j]);
            u32x4 o; o.x = cvt_pk_bf16(y[0], y[1]); o.y = cvt_pk_bf16(y[2], y[3]); o.z = cvt_pk_bf16(y[4], y[5]); o.w = cvt_pk_bf16(y[6], y[7]);
            *(LAS u32x4*)(lds + L_B + (l0 + t) * LROW + n0 * 2) = o;
        }
    }
    const int l = 16 * wid + fr;
    bf16x8 Cf[4];
#pragma unroll
    for (int ks = 0; ks < 4; ++ks) {
        const int n0 = 32 * ks + 8 * fq, cc = 3072 + 128 * g + n0;
        const bf16_t* src = proj + COL_C + 128 * g + n0;
        float y[8];
        { const f32x4 a = *(const f32x4*)(P.cb + cc), a2 = *(const f32x4*)(P.cb + cc + 4); y[0] = a.x; y[1] = a.y; y[2] = a.z; y[3] = a.w; y[4] = a2.x; y[5] = a2.y; y[6] = a2.z; y[7] = a2.w; }
#pragma unroll
        for (int k = 0; k < 4; ++k) {
            const u32x4 q = *(const u32x4*)(src + (R0 + l - 3 + k) * LDP);
            const f32x4 a = *(const f32x4*)(P.cw + k * 4096 + cc), a2 = *(const f32x4*)(P.cw + k * 4096 + cc + 4);
            y[0] += a.x * bf_lo(q.x); y[1] += a.y * bf_hi(q.x); y[2] += a.z * bf_lo(q.y); y[3] += a.w * bf_hi(q.y);
            y[4] += a2.x * bf_lo(q.z); y[5] += a2.y * bf_hi(q.z); y[6] += a2.z * bf_lo(q.w); y[7] += a2.w * bf_hi(q.w);
        }
#pragma unroll
        for (int j = 0; j < 8; ++j) y[j] = silu_f(y[j]);
        u32x4 o; o.x = cvt_pk_bf16(y[0], y[1]); o.y = cvt_pk_bf16(y[2], y[3]); o.z = cvt_pk_bf16(y[4], y[5]); o.w = cvt_pk_bf16(y[6], y[7]);
        Cf[ks] = __builtin_bit_cast(bf16x8, o);
    }
#pragma unroll
    for (int i = 0; i < 2; ++i) { const int e = tid + 512 * i; *(LAS u32x4*)(lds + L_P0 + (e >> 4) * LROW + (e & 15) * 16) = pf[i]; }
    __syncthreads();
    f32x4 cbt[8];
#pragma unroll
    for (int T = 0; T < 8; ++T) { cbt[T] = (f32x4){0.f, 0.f, 0.f, 0.f};
#pragma unroll
        for (int ks = 0; ks < 4; ++ks) { const bf16x8 af = *(const LAS bf16x8*)(lds + L_B + (16 * T + fr) * LROW + (32 * ks + 8 * fq) * 2);
            cbt[T] = __builtin_amdgcn_mfma_f32_16x16x32_bf16(af, Cf[ks], cbt[T], 0, 0, 0); } }
    f32x4 yr0[4], yr1[4], yr2[4], yr3[4]; float ssq = 0.f;
#pragma unroll
    for (int pt = 0; pt < 4; ++pt) { yr0[pt] = yr1[pt] = yr2[pt] = yr3[pt] = (f32x4){0.f, 0.f, 0.f, 0.f}; }
#pragma unroll 1
    for (int hh = 0; hh < 4; ++hh) {
        if (hh < 3) {
#pragma unroll
            for (int i = 0; i < 2; ++i) pf[i] = *(const u32x4*)(prevg + (size_t)(hh + 1) * 8192 + (size_t)(tid + 512 * i) * 8);
        }
        const LAS float* cs = (const LAS float*)(lds + L_CS) + hh * 128; const LAS float* dt = (const LAS float*)(lds + L_DT) + hh * 128;
        const float csl = cs[l], Dh = P.dsk[4 * g + hh];
        f32x4 yd[4], yo[4];
#pragma unroll
        for (int pt = 0; pt < 4; ++pt) { yd[pt] = (f32x4){0.f, 0.f, 0.f, 0.f}; yo[pt] = (f32x4){0.f, 0.f, 0.f, 0.f}; }
#pragma unroll
        for (int q = 0; q < 4; ++q) {
            float pv[8];
#pragma unroll
            for (int hf = 0; hf < 2; ++hf) {
                const int T = 2 * q + hf, s0 = 16 * T + 4 * fq;
                const f32x4 c4 = *(const LAS f32x4*)(cs + s0), d4 = *(const LAS f32x4*)(dt + s0);
#pragma unroll
                for (int r = 0; r < 4; ++r) {
                    const int s = s0 + r;
                    const float e = (s <= l) ? __expf(fminf(csl - c4[r], 0.f)) * d4[r] : 0.f;
                    float v = cbt[T][r] * e; if (s == l) v += Dh;
                    pv[hf * 4 + r] = v;
                }
            }
            u32x4 o; o.x = cvt_pk_bf16(pv[0], pv[1]); o.y = cvt_pk_bf16(pv[2], pv[3]); o.z = cvt_pk_bf16(pv[4], pv[5]); o.w = cvt_pk_bf16(pv[6], pv[7]);
            const bf16x8 pfr = __builtin_bit_cast(bf16x8, o);
#pragma unroll
            for (int pt = 0; pt < 4; ++pt) {
                const LAS unsigned char* xr = lds + L_X + (64 * hh + 16 * pt + fr) * LROW + (32 * q + 4 * fq) * 2;
                const u32x2 lo = *(const LAS u32x2*)xr, hi = *(const LAS u32x2*)(xr + 32);
                const u32x4 xx = (u32x4){lo.x, lo.y, hi.x, hi.y};
                yd[pt] = __builtin_amdgcn_mfma_f32_16x16x32_bf16(__builtin_bit_cast(bf16x8, xx), pfr, yd[pt], 0, 0, 0);
            }
        }
        const int pbuf = (hh & 1) ? L_P1 : L_P0;
#pragma unroll
        for (int ks = 0; ks < 4; ++ks)
#pragma unroll
            for (int pt = 0; pt < 4; ++pt) { const bf16x8 pa = *(const LAS bf16x8*)(lds + pbuf + (16 * pt + fr) * LROW + (32 * ks + 8 * fq) * 2);
                yo[pt] = __builtin_amdgcn_mfma_f32_16x16x32_bf16(pa, Cf[ks], yo[pt], 0, 0, 0); }
        const float el = __expf(csl);
#pragma unroll
        for (int pt = 0; pt < 4; ++pt) {
            const u32x2 zz = *(const u32x2*)(proj + (R0 + l) * LDP + COL_Z + 256 * g + 64 * hh + 16 * pt + 4 * fq);
            const float z0 = bf_lo(zz.x), z1 = bf_hi(zz.x), z2 = bf_lo(zz.y), z3 = bf_hi(zz.y);
            f32x4 v = yd[pt] + yo[pt] * el;
            v.x *= silu_f(z0); v.y *= silu_f(z1); v.z *= silu_f(z2); v.w *= silu_f(z3);
            ssq += (v.x * v.x + v.y * v.y) + (v.z * v.z + v.w * v.w);
            yr3[pt] = yr2[pt]; yr2[pt] = yr1[pt]; yr1[pt] = yr0[pt]; yr0[pt] = v;
        }
        if (hh < 3) {
            const int nbuf = (hh & 1) ? L_P0 : L_P1;
#pragma unroll
            for (int i = 0; i < 2; ++i) { const int e = tid + 512 * i; *(LAS u32x4*)(lds + nbuf + (e >> 4) * LROW + (e & 15) * 16) = pf[i]; }
        }
        __syncthreads();
    }
    ssq += __shfl_xor(ssq, 16); ssq += __shfl_xor(ssq, 32);
    const float rs = rsqrtf(ssq * (1.f / 256.f) + EPS);
#pragma unroll
    for (int hh = 0; hh < 4; ++hh)
#pragma unroll
        for (int pt = 0; pt < 4; ++pt) {
            const int ch = 256 * g + 64 * hh + 16 * pt + 4 * fq;
            const f32x4 gg = *(const f32x4*)(P.sng + ch);
            const f32x4 v = (hh == 0) ? yr3[pt] : (hh == 1) ? yr2[pt] : (hh == 2) ? yr1[pt] : yr0[pt];
            *(u32x2*)(proj + (R0 + l) * LDP + COL_Z + ch) = (u32x2){cvt_pk_bf16(v.x * rs * gg.x, v.y * rs * gg.y), cvt_pk_bf16(v.z * rs * gg.z, v.w * rs * gg.w)};
        }
}

__device__ __forceinline__ void post_mix_phase(const Params& P) {
    const int lane = threadIdx.x & 63, gw = blockIdx.x * 8 + (threadIdx.x >> 6), NGW = gridDim.x * 8;
    bf16_t* H1N = (bf16_t*)(P.ws + WS_TAIL);
    for (int r = gw; r < MR; r += NGW) {
        f32x4* mr = (f32x4*)(P.out + (size_t)r * DM) + lane; const f32x4* xr = (const f32x4*)(P.x + (size_t)r * DM) + lane;
        const f32x4* g1 = (const f32x4*)P.g_postmix + lane; const f32x4* g2 = (const f32x4*)P.g_premlp + lane;
        f32x4 v[8]; float s = 0.f;
#pragma unroll
        for (int j = 0; j < 8; ++j) { v[j] = mr[64 * j]; s += (v[j].x * v[j].x + v[j].y * v[j].y) + (v[j].z * v[j].z + v[j].w * v[j].w); }
        const float rs = rsqrtf(wave_sum(s) * (1.f / DM) + EPS);
        float s2 = 0.f;
#pragma unroll
        for (int j = 0; j < 8; ++j) { const f32x4 xx = xr[64 * j], gg = g1[64 * j]; v[j] = xx + v[j] * rs * gg; s2 += (v[j].x * v[j].x + v[j].y * v[j].y) + (v[j].z * v[j].z + v[j].w * v[j].w); mr[64 * j] = v[j]; }
        const float rs2 = rsqrtf(wave_sum(s2) * (1.f / DM) + EPS);
        u32x2* o8 = (u32x2*)(H1N + (size_t)r * DM) + lane;
#pragma unroll
        for (int j = 0; j < 8; ++j) { const f32x4 gg = g2[64 * j]; o8[64 * j] = (u32x2){cvt_pk_bf16(v[j].x * rs2 * gg.x, v[j].y * rs2 * gg.y), cvt_pk_bf16(v[j].z * rs2 * gg.z, v[j].w * rs2 * gg.w)}; }
    }
}
__device__ __forceinline__ void final_phase(const Params& P) {
    const int lane = threadIdx.x & 63, gw = blockIdx.x * 8 + (threadIdx.x >> 6), NGW = gridDim.x * 8;
    const float* FF = (const float*)(P.ws + WS_FF);
    for (int r = gw; r < MR; r += NGW) {
        f32x4* hr = (f32x4*)(P.out + (size_t)r * DM) + lane; const f32x4* fr_ = (const f32x4*)(FF + (size_t)r * DM) + lane;
        const f32x4* g1 = (const f32x4*)P.g_postmlp + lane;
        f32x4 v[8]; float s = 0.f;
#pragma unroll
        for (int j = 0; j < 8; ++j) { v[j] = fr_[64 * j]; s += (v[j].x * v[j].x + v[j].y * v[j].y) + (v[j].z * v[j].z + v[j].w * v[j].w); }
        const float rs = rsqrtf(wave_sum(s) * (1.f / DM) + EPS);
#pragma unroll
        for (int j = 0; j < 8; ++j) { const f32x4 hh = hr[64 * j], gg = g1[64 * j]; hr[64 * j] = hh + v[j] * rs * gg; }
    }
}

extern __shared__ __attribute__((aligned(16))) unsigned char dyn_lds[];

__global__ void __launch_bounds__(512) hymba_fwd(Params P) {
    cg::grid_group grid = cg::this_grid();
    LAS unsigned char* lds = (LAS unsigned char*)dyn_lds;
    const int G = gridDim.x;
    pg8::StaticOrder S;
#ifndef SKIP_P0
    phase0(P, lds);
#endif
    grid.sync();
    { pg8::Gemm gm{(const bf16_t*)P.out, (const bf16_t*)(P.ws + WS_TAIL), TP / 256, LDP / 256, DM, DM, 0};
      S.init(gm.nM, gm.nN, G, blockIdx.x);
      pg8::EpiBf16<0> E{(bf16_t*)(P.ws + WS_PROJ), LDP};
#ifndef SKIP_GEMM
      pg8::gemm_phase(lds, gm, S, E);
#endif
    }
    grid.sync();
#ifndef SKIP_P2
    for (int u = blockIdx.x; u < NBATCH * 128 * 8; u += G) ssd_states_unit(P, lds, u);
#endif
#ifndef SKIP_SC
    for (int t = blockIdx.x * 8 + (threadIdx.x >> 6); t < (MR / 32) * 4; t += G * 8) shortconv_task(P, t, threadIdx.x & 63);
#endif
    grid.sync();
#ifndef SKIP_P3
    scan_phase(P);
#endif
    grid.sync();
#ifndef SKIP_P4
    for (int u = blockIdx.x; u < NBATCH * 128 * 8; u += G) ssd_out_unit(P, lds, u);
#endif
    grid.sync();
    { pg8::Gemm gm{(const bf16_t*)(P.ws + WS_PROJ), (const bf16_t*)(P.ws + WS_WOUT), MR / 256, DM / 256, DMIX, LDP, 1};
      S.init(gm.nM, gm.nN, G, blockIdx.x);
      pg8::EpiF32 E{P.out, DM};
#ifndef SKIP_GEMM
      pg8::gemm_phase(lds, gm, S, E);
#endif
    }
    grid.sync();
#ifndef SKIP_P6
    post_mix_phase(P);
#endif
    grid.sync();
    { pg8::Gemm gm{(const bf16_t*)(P.ws + WS_TAIL), (const bf16_t*)(P.ws + WS_W1), MR / 256, DFF / 256, DM, DM, 0};
      S.init(gm.nM, gm.nN, G, blockIdx.x);
      pg8::EpiBf16<1> E{(bf16_t*)(P.ws + WS_HID), DFF};
#ifndef SKIP_GEMM
      pg8::gemm_phase(lds, gm, S, E);
#endif
    }
    grid.sync();
    { pg8::Gemm gm{(const bf16_t*)(P.ws + WS_HID), (const bf16_t*)(P.ws + WS_W2), MR / 256, DM / 256, DFF, DFF, 0};
      S.init(gm.nM, gm.nN, G, blockIdx.x);
      pg8::EpiF32 E{(float*)(P.ws + WS_FF), DM};
#ifndef SKIP_GEMM
      pg8::gemm_phase(lds, gm, S, E);
#endif
    }
    grid.sync();
#ifndef SKIP_P9
    final_phase(P);
#endif
}

extern "C" void kernel_launch(void* const* d_in, const int* in_sizes, int n_in, void* d_out, int out_size, void* d_ws, size_t ws_size, hipStream_t stream) {
    static int grid = 0;
    if (!grid) {
        if (n_in != 18 || ws_size < WS_END) { fprintf(stderr, "kernel_launch: unexpected n_in %d / ws %zu (need %zu)\n", n_in, ws_size, (size_t)WS_END); grid = -1; return; }
        int dev = 0, cus = 0, per_cu = 0;
        (void)hipGetDevice(&dev);
        (void)hipDeviceGetAttribute(&cus, hipDeviceAttributeMultiprocessorCount, dev);
        (void)hipFuncSetAttribute((const void*)hymba_fwd, hipFuncAttributeMaxDynamicSharedMemorySize, LDS_BYTES);
        (void)hipOccupancyMaxActiveBlocksPerMultiprocessor(&per_cu, (const void*)hymba_fwd, 512, LDS_BYTES);
        if (per_cu < 1) { fprintf(stderr, "kernel_launch: occupancy query says %d blocks per CU\n", per_cu); per_cu = 1; }
        grid = cus;
    }
    if (grid < 0) return;
    Params p{};
    const float** f = (const float**)&p;
    for (int i = 0; i < 18; ++i) f[i] = (const float*)d_in[i];
    p.out = (float*)d_out; p.ws = (unsigned char*)d_ws;
    void* args[] = {&p};
    hipError_t e = hipLaunchCooperativeKernel((const void*)hymba_fwd, dim3(grid), dim3(512), args, LDS_BYTES, stream);
    if (e != hipSuccess) fprintf(stderr, "cooperative launch failed: %s (grid %d)\n", hipGetErrorString(e), grid);
}
```

```cpp
#define EPI_NT 1
#define PG8_SP2 true
#define PG8_ALIGN true
#include <hip/hip_runtime.h>
#include <hip/hip_cooperative_groups.h>
#include <cstdio>
namespace cg = cooperative_groups;

#define LAS __attribute__((address_space(3)))
typedef unsigned short bf16_t;
typedef short bf16x8 __attribute__((ext_vector_type(8)));
typedef float f32x4 __attribute__((ext_vector_type(4)));
typedef float f32x2 __attribute__((ext_vector_type(2)));
typedef unsigned u32x4 __attribute__((ext_vector_type(4)));
typedef unsigned u32x2 __attribute__((ext_vector_type(2)));

constexpr int DM = 2048, NBATCH = 2, SEQ = 16384, NMETA = 16;
constexpr int LP = 16512;
constexpr int TP = NBATCH * LP;
constexpr int MR = NBATCH * SEQ;
constexpr int NIN = 12320, NPAD = 12544;
constexpr int LDP = 10496;
constexpr int COL_GB = 0, COL_Z = 2048, COL_U = 4096, COL_X = 6144, COL_B = 8192, COL_C = 9216, COL_DT = 10240;
constexpr int DFF = 8192, DMIX = 4096;
constexpr float EPS = 1e-6f;
constexpr int LDS_SSD = 147456, LDS_EPI = 131072 + 8 * 2304, LDS_MAIN = LDS_EPI > LDS_SSD ? LDS_EPI : LDS_SSD, LDS_BYTES = LDS_MAIN + 64;

constexpr size_t WS_WOUT = 0;
constexpr size_t WS_W1 = WS_WOUT + (size_t)DM * DMIX * 2;
constexpr size_t WS_W2 = WS_W1 + (size_t)DFF * DM * 2;
constexpr size_t WS_PROJ = WS_W2 + (size_t)DM * DFF * 2;
constexpr size_t WS_PROJ_BYTES = (size_t)MR * DFF * 2 + (size_t)MR * DM * 4;
static_assert(WS_PROJ_BYTES >= (size_t)TP * LDP * 2, "proj");
constexpr size_t WS_TAIL = WS_PROJ + WS_PROJ_BYTES;
constexpr size_t WS_TAIL_BYTES = (size_t)MR * DM * 2;
constexpr size_t WS_DEC = WS_TAIL + WS_TAIL_BYTES;
constexpr size_t WS_BAR = WS_DEC + (size_t)NBATCH * 128 * 32 * 4;
constexpr size_t WS_END = WS_BAR + 3456 * 4;
constexpr size_t WS_HID = WS_PROJ;
constexpr size_t WS_FF = WS_PROJ + (size_t)MR * DFF * 2;

struct Params {
    const float *x, *meta, *w_in, *scw, *cng, *cw, *cb, *dtb, *alog, *dsk, *sng, *w_out, *g_premix, *g_postmix, *g_premlp, *g_postmlp, *w1, *w2;
    float* out; unsigned char* ws;
};

__device__ __forceinline__ unsigned cvt_pk_bf16(float lo, float hi) { unsigned r; asm volatile("v_cvt_pk_bf16_f32 %0, %1, %2" : "=v"(r) : "v"(lo), "v"(hi)); return r; }
__device__ __forceinline__ unsigned pk_bf16_sw(float lo, float hi) { unsigned a = __float_as_uint(lo), b = __float_as_uint(hi); a += 0x7FFFu + ((a >> 16) & 1u); b += 0x7FFFu + ((b >> 16) & 1u); return (a >> 16) | (b & 0xffff0000u); }
__device__ __forceinline__ float bf_lo(unsigned w) { return __uint_as_float(w << 16); }
__device__ __forceinline__ float bf_hi(unsigned w) { return __uint_as_float(w & 0xffff0000u); }
__device__ __forceinline__ float bf2f(bf16_t b) { return __uint_as_float(((unsigned)b) << 16); }
__device__ __forceinline__ float wave_sum(float v) {
#pragma unroll
    for (int o = 1; o < 64; o <<= 1) v += __shfl_xor(v, o);
    return v;
}
__device__ __forceinline__ int opaque_tid() { int t = threadIdx.x; asm volatile("" : "+v"(t)); return t; }
__device__ __forceinline__ float silu_f(float v) { return v * __builtin_amdgcn_rcpf(1.0f + __expf(-v)); }
__device__ __forceinline__ float softplus_f(float v) { return fmaxf(v, 0.f) + log1pf(__expf(-fabsf(v))); }

#ifndef PROBE_NOEPI
#define PROBE_NOEPI false
#endif
namespace pg8 {
#ifdef EPI_NT
#define EPI_STORE(p, v) __builtin_nontemporal_store((v), (p))
#else
#define EPI_STORE(p, v) (*(p) = (v))
#endif
constexpr int BM = 256, BK = 64, HALF = 128, HTB = HALF * BK * 2, STAGE_BYTES = 8 * HTB, NXCD = 8, WGM = 4;
#ifndef PG8_ROWMAJOR
#define PG8_ROWMAJOR 1
#endif
#if PG8_ROWMAJOR
__host__ __device__ __forceinline__ int lds_byte(int r, int c) { return r * 128 + ((((c >> 3) ^ ((r >> 1) & 7)) & 7) << 4) + (c & 7) * 2; }
__host__ __device__ __forceinline__ void stage_rc(int b, int& R, int& C) { R = b / 128; const int ch = (b % 128) / 16; C = ((ch ^ ((R >> 1) & 7)) & 7) * 8; }
#else
__host__ __device__ __forceinline__ int lds_byte(int r, int c) { const int st = (r >> 4) * 2 + (c >> 5), rr = r & 15, cc = c & 31, ob = rr * 64 + cc * 2; return st * 1024 + (ob ^ (((ob >> 9) & 1) << 5)); }
__host__ __device__ __forceinline__ void stage_rc(int b, int& R, int& C) { const int st = b / 1024, sb = b % 1024, swz = sb ^ (((sb >> 9) & 1) << 5); R = (st >> 1) * 16 + swz / 64; C = (st & 1) * 32 + (swz % 64) / 2; }
#endif
__host__ __device__ __forceinline__ int perm32(int rho) { const int n = rho >> 4, i = rho & 15; return 8 * (i >> 2) + 4 * n + (i & 3); }

struct Unit { int pm, pn; };
struct Gemm { const bf16_t* A; const bf16_t* Bt; int nM, nN, K, lda, amode; };

struct StaticOrder {
    int nM, nN, nwg, G, c; bool same = false;
    __device__ void init(int nM_, int nN_, int G_, int c_) { nM = nM_; nN = nN_; nwg = nM * nN; G = G_; c = c_; }
    __device__ bool next(int i, Unit& u) const {
        const long L = (long)i * G + c; if (L >= nwg) return false;
        int wgid = (int)L; { const int q = nwg / NXCD, r = nwg % NXCD, xcd = wgid % NXCD, off = wgid / NXCD; wgid = (xcd < r ? xcd * (q + 1) : r * (q + 1) + (xcd - r) * q) + off; }
        const int nig = WGM * nN, gid = wgid / nig, fm = gid * WGM, gsz = (nM - fm) < WGM ? (nM - fm) : WGM;
        u.pm = fm + ((wgid % nig) % gsz); u.pn = (wgid % nig) / gsz;
#ifdef PROBE_SAMETILE
        if (same) { u.pm = 0; u.pn = 0; }
#endif
        return true;
    }
};

struct EpiF32 {
    static constexpr bool PERM = false;
    float* C; int ldc;
    __device__ __forceinline__ void operator()(const f32x4 (&acc)[2][2][4][2], const Unit& u, int wr, int wc, int fr, int fq) const {
        const int row0 = u.pm * BM + wr * 64 + fr, col0 = u.pn * BM + wc * 32 + 4 * fq;
#pragma unroll
        for (int ai = 0; ai < 2; ++ai)
#pragma unroll
            for (int m = 0; m < 4; ++m) { float* rowp = C + (size_t)(row0 + ai * HALF + m * 16) * ldc + col0;
#pragma unroll
                for (int bj = 0; bj < 2; ++bj)
#pragma unroll
                    for (int n = 0; n < 2; ++n) EPI_STORE((f32x4*)(rowp + bj * HALF + n * 16), acc[ai][bj][m][n]); }
    }
};
constexpr int EPI_STG_PITCH = 144, EPI_STG_BYTES = 16 * EPI_STG_PITCH;
__device__ __forceinline__ void epi_store_rows(LAS unsigned char* stg, bf16_t* gbase, size_t ldc, const u32x4& w0, const u32x4& w1, int fr, int fq) {
    *(LAS u32x4*)(stg + fr * EPI_STG_PITCH + fq * 16) = w0;
    *(LAS u32x4*)(stg + fr * EPI_STG_PITCH + (4 + fq) * 16) = w1;
    const int lane = fr + 16 * fq, rr = lane >> 3, cc = lane & 7;
    const u32x4 a = *(const LAS u32x4*)(stg + rr * EPI_STG_PITCH + cc * 16);
    const u32x4 b = *(const LAS u32x4*)(stg + (8 + rr) * EPI_STG_PITCH + cc * 16);
    EPI_STORE((u32x4*)(gbase + (size_t)rr * ldc + cc * 8), a);
    EPI_STORE((u32x4*)(gbase + (size_t)(8 + rr) * ldc + cc * 8), b);
}
template <int ACT  > struct EpiBf16 {
    static constexpr bool PERM = true;
    bf16_t* O; int ldc; LAS unsigned char* stg;
    __device__ __forceinline__ void operator()(const f32x4 (&acc)[2][2][4][2], const Unit& u, int wr, int wc, int fr, int fq) const {
        bf16_t* tile = O + (size_t)(u.pm * BM + wr * 64) * ldc + u.pn * BM + wc * 64;
#pragma unroll
        for (int ai = 0; ai < 2; ++ai)
#pragma unroll
            for (int m = 0; m < 4; ++m) {
                u32x4 w[2];
#pragma unroll
                for (int bj = 0; bj < 2; ++bj) { f32x4 v0 = acc[ai][bj][m][0], v1 = acc[ai][bj][m][1];
                    if (ACT == 1) {
#pragma unroll
                        for (int j = 0; j < 4; ++j) { const float a = fmaxf(v0[j], 0.f), b = fmaxf(v1[j], 0.f); v0[j] = a * a; v1[j] = b * b; } }
                    w[bj].x = cvt_pk_bf16(v0[0], v0[1]); w[bj].y = cvt_pk_bf16(v0[2], v0[3]); w[bj].z = cvt_pk_bf16(v1[0], v1[1]); w[bj].w = cvt_pk_bf16(v1[2], v1[3]); }
                epi_store_rows(stg, tile + (size_t)(ai * HALF + m * 16) * ldc, ldc, w[0], w[1], fr, fq); }
    }
};

struct EpiInProj {
    static constexpr bool PERM = true;
    bf16_t* O; LAS unsigned char* stg;
    __device__ __forceinline__ void operator()(const f32x4 (&acc)[2][2][4][2], const Unit& u, int wr, int wc, int fr, int fq) const {
        const int row0 = u.pm * BM + wr * 64 + fr;
        if (u.pn >= 16 && u.pn < 32) {
            const int col0 = COL_U + 128 * (u.pn - 16) + wc * 32 + 8 * fq;
#pragma unroll
            for (int ai = 0; ai < 2; ++ai)
#pragma unroll
                for (int m = 0; m < 4; ++m) { bf16_t* rowp = O + (size_t)(row0 + ai * HALF + m * 16) * LDP + col0;
                    const f32x4 v0 = acc[ai][0][m][0] * acc[ai][1][m][0], v1 = acc[ai][0][m][1] * acc[ai][1][m][1];
                    u32x4 w; w.x = cvt_pk_bf16(v0[0], v0[1]); w.y = cvt_pk_bf16(v0[2], v0[3]); w.z = cvt_pk_bf16(v1[0], v1[1]); w.w = cvt_pk_bf16(v1[2], v1[3]);
                    EPI_STORE((u32x4*)rowp, w); }
        } else {
            bf16_t* tile = O + (size_t)(u.pm * BM + wr * 64) * LDP + (u.pn < 16 ? 256 * u.pn : COL_X + 256 * (u.pn - 32)) + wc * 64;
#pragma unroll
            for (int ai = 0; ai < 2; ++ai)
#pragma unroll
                for (int m = 0; m < 4; ++m) {
                    u32x4 w[2];
#pragma unroll
                    for (int bj = 0; bj < 2; ++bj) { const f32x4 v0 = acc[ai][bj][m][0], v1 = acc[ai][bj][m][1];
                        w[bj].x = cvt_pk_bf16(v0[0], v0[1]); w[bj].y = cvt_pk_bf16(v0[2], v0[3]); w[bj].z = cvt_pk_bf16(v1[0], v1[1]); w[bj].w = cvt_pk_bf16(v1[2], v1[3]); }
                    epi_store_rows(stg, tile + (size_t)(ai * HALF + m * 16) * LDP, LDP, w[0], w[1], fr, fq); }
        }
    }
};
#ifndef PG8_SP2
#define PG8_SP2 false
#endif
#ifndef PG8_ALIGN
#define PG8_ALIGN false
#endif
template <class Epi, bool NOEPI = false, bool SP2 = PG8_SP2, bool ALIGN_EPI = PG8_ALIGN, bool ANT = false>
__device__ __forceinline__ void gemm_phase(LAS unsigned char* lds, const Gemm g, const StaticOrder& S, const Epi& E) {
    const int tid = opaque_tid(), wid = __builtin_amdgcn_readfirstlane(tid >> 6), lane = tid & 63, wr = wid >> 2, wc = wid & 3, fr = lane & 15, fq = lane >> 4;
    const int K = g.K, nt = K / BK, lda = g.lda;
    unsigned voffA[2], voffB[2], voffB1[2];
#pragma unroll
    for (int i = 0; i < 2; ++i) { int R, C; stage_rc(tid * 16 + i * 8192, R, C); const int Rb = Epi::PERM ? ((R & ~31) + perm32(R & 31)) : R;
        const int Rb0 = Epi::PERM ? (64 * (R >> 5) + perm32(R & 31)) : R, Rb1 = Epi::PERM ? (64 * (R >> 5) + 32 + perm32(R & 31)) : (HALF + R); (void)Rb;
        voffA[i] = (unsigned)(R * lda + C) * 2u; voffB[i] = (unsigned)(Rb0 * K + C) * 2u; voffB1[i] = (unsigned)(Rb1 * K + C) * 2u; }
    const size_t kstep = (size_t)(BK * 2);
    const size_t hstepA = (size_t)HALF * lda * 2, hstepB = (size_t)HALF * K * 2;
    const unsigned ldsw = (unsigned)wid * 1024u;
    const int aoff[2] = {lds_byte(wr * 64 + fr, fq * 8), lds_byte(wr * 64 + fr, 32 + fq * 8)}, boff[2] = {lds_byte(wc * 32 + fr, fq * 8), lds_byte(wc * 32 + fr, 32 + fq * 8)};
#define PG8_SA(b, h) (((b) * 2 + (h)) * HTB)
#define PG8_SB(b, h) ((4 + (b) * 2 + (h)) * HTB)
#define PG8_STAGE(bufoff, gbase, voff) do { _Pragma("unroll") for (int _i = 0; _i < 2; ++_i) \
        __builtin_amdgcn_global_load_lds((const unsigned*)((const char*)(gbase) + (voff)[_i]), (LAS unsigned*)(lds + (bufoff) + ldsw + _i * 8192), 16, 0, 0); } while (0)
#define PG8_STAGEA(bufoff, gbase, voff) do { _Pragma("unroll") for (int _i = 0; _i < 2; ++_i) \
        __builtin_amdgcn_global_load_lds((const unsigned*)((const char*)(gbase) + (voff)[_i]), (LAS unsigned*)(lds + (bufoff) + ldsw + _i * 8192), 16, 0, ANT ? 2 : 0); } while (0)
#define PG8_LDA(dst, b, h) do { _Pragma("unroll") for (int m = 0; m < 4; ++m) _Pragma("unroll") for (int k = 0; k < 2; ++k) dst[m][k] = *(const LAS bf16x8*)(lds + PG8_SA(b, h) + aoff[k] + m * 2048); } while (0)
#define PG8_LDB(dst, b, h) do { _Pragma("unroll") for (int n = 0; n < 2; ++n) _Pragma("unroll") for (int k = 0; k < 2; ++k) dst[n][k] = *(const LAS bf16x8*)(lds + PG8_SB(b, h) + boff[k] + n * 2048); } while (0)
#define PG8_MMA(ai, bj, At, Bt) do { __builtin_amdgcn_s_setprio(1); _Pragma("unroll") for (int m = 0; m < 4; ++m) _Pragma("unroll") for (int n = 0; n < 2; ++n) _Pragma("unroll") for (int k = 0; k < 2; ++k) \
        acc[ai][bj][m][n] = __builtin_amdgcn_mfma_f32_16x16x32_bf16(Bt[n][k], At[m][k], acc[ai][bj][m][n], 0, 0, 0); __builtin_amdgcn_s_setprio(0); } while (0)
#define PG8_WAIT_V(n) asm volatile("s_waitcnt vmcnt(" #n ")" ::: "memory")
#define PG8_WAIT_L(n) asm volatile("s_waitcnt lgkmcnt(" #n ")" ::: "memory")
#define PG8_BAR __builtin_amdgcn_s_barrier()
#define PG8_SCHED __builtin_amdgcn_sched_barrier(0)
#define PG8_AROW(pm) ((size_t)((pm) * BM + (g.amode ? 128 + 128 * ((pm) >> 6) : 0)))
    Unit cur, nxt; int ui = 0;
    if (!S.next(0, cur)) return;
#ifdef STAGGER_TICKS
#ifndef STAGGER_XCD
#define STAGGER_XCD 0
#endif
    { const unsigned long long t0 = __builtin_amdgcn_s_memrealtime(), dl = (unsigned long long)(STAGGER_XCD ? (S.c & 7) : (S.c >> 3)) * STAGGER_TICKS;
      while (__builtin_amdgcn_s_memrealtime() - t0 < dl) __builtin_amdgcn_s_sleep(8); }
#endif
    f32x4 acc[2][2][4][2];
#pragma unroll
    for (int a = 0; a < 2; ++a)
#pragma unroll
        for (int b = 0; b < 2; ++b)
#pragma unroll
            for (int m = 0; m < 4; ++m)
#pragma unroll
                for (int n = 0; n < 2; ++n) acc[a][b][m][n] = (f32x4){0.f, 0.f, 0.f, 0.f};
    bf16x8 At[4][2], B0[2][2], B1[2][2];
    const char* cA = (const char*)g.A + PG8_AROW(cur.pm) * lda * 2; const char* cB = (const char*)g.Bt + (size_t)cur.pn * BM * K * 2;
    if constexpr (SP2) {
        PG8_STAGE(PG8_SB(0, 0), cB, voffB); PG8_STAGE(PG8_SB(0, 1), cB, voffB1); PG8_STAGEA(PG8_SA(0, 0), cA, voffA); PG8_STAGEA(PG8_SA(0, 1), cA + hstepA, voffA);
        if (wr == 1) PG8_BAR;
        PG8_WAIT_V(2); PG8_BAR;
        PG8_STAGE(PG8_SB(1, 0), cB + kstep, voffB); PG8_STAGEA(PG8_SA(1, 0), cA + kstep, voffA); PG8_STAGE(PG8_SB(1, 1), cB + kstep, voffB1);
        PG8_WAIT_V(6); PG8_BAR;
    } else {
    PG8_STAGE(PG8_SB(0, 0), cB, voffB); PG8_STAGEA(PG8_SA(0, 0), cA, voffA); PG8_STAGE(PG8_SB(0, 1), cB, voffB1); PG8_STAGEA(PG8_SA(0, 1), cA + hstepA, voffA);
    if (wr == 1) PG8_BAR;
    PG8_WAIT_V(4); PG8_BAR;
    PG8_STAGE(PG8_SB(1, 0), cB + kstep, voffB); PG8_STAGEA(PG8_SA(1, 0), cA + kstep, voffA); PG8_STAGE(PG8_SB(1, 1), cB + kstep, voffB1);
    PG8_WAIT_V(6); PG8_BAR;
    }
    for (;;) {
        const bool has_next = S.next(ui + 1, nxt);
        const char* nA = has_next ? (const char*)g.A + PG8_AROW(nxt.pm) * lda * 2 : cA; const char* nB = has_next ? (const char*)g.Bt + (size_t)nxt.pn * BM * K * 2 : cB;
        for (int t = 0; t < nt; t += 2) {
            const bool last = (t == nt - 2);
            const char* a1 = cA + (size_t)(t + 1) * kstep;
            const char* a2 = last ? nA : cA + (size_t)(t + 2) * kstep; const char* b2 = last ? nB : cB + (size_t)(t + 2) * kstep;
            const char* a3 = a2 + kstep; const char* b3 = b2 + kstep;
            if constexpr (SP2) {
            PG8_LDB(B0, 0, 0); PG8_LDB(B1, 0, 1); PG8_SCHED; PG8_LDA(At, 0, 0); PG8_STAGEA(PG8_SA(1, 1), a1 + hstepA, voffA);
            PG8_WAIT_V(8); PG8_WAIT_L(0); PG8_BAR; PG8_MMA(0, 0, At, B0); PG8_MMA(0, 1, At, B1); PG8_BAR; PG8_SCHED;
            PG8_LDA(At, 0, 1); PG8_STAGE(PG8_SB(0, 0), b2, voffB); PG8_STAGE(PG8_SB(0, 1), b2, voffB1); PG8_STAGEA(PG8_SA(0, 0), a2, voffA);
            PG8_WAIT_V(8); PG8_WAIT_L(0); PG8_BAR; PG8_MMA(1, 0, At, B0); PG8_MMA(1, 1, At, B1); PG8_BAR; PG8_SCHED;
            PG8_LDB(B0, 1, 0); PG8_LDB(B1, 1, 1); PG8_SCHED; PG8_LDA(At, 1, 0); PG8_STAGEA(PG8_SA(0, 1), a2 + hstepA, voffA);
            PG8_WAIT_V(8); PG8_WAIT_L(0); PG8_BAR; PG8_MMA(0, 0, At, B0); PG8_MMA(0, 1, At, B1); PG8_BAR; PG8_SCHED;
            PG8_LDA(At, 1, 1); PG8_STAGE(PG8_SB(1, 0), b3, voffB); PG8_STAGE(PG8_SB(1, 1), b3, voffB1); PG8_STAGEA(PG8_SA(1, 0), a3, voffA);
            PG8_WAIT_V(8); PG8_WAIT_L(0); PG8_BAR; PG8_MMA(1, 0, At, B0); PG8_MMA(1, 1, At, B1); PG8_BAR; PG8_SCHED;
            } else {
            PG8_LDB(B0, 0, 0); PG8_SCHED; PG8_LDA(At, 0, 0); PG8_STAGEA(PG8_SA(1, 1), a1 + hstepA, voffA);
            PG8_WAIT_L(8); PG8_BAR; PG8_WAIT_L(0); PG8_MMA(0, 0, At, B0); PG8_BAR; PG8_SCHED;
            PG8_LDB(B1, 0, 1); PG8_STAGE(PG8_SB(0, 0), b2, voffB);
            PG8_BAR; PG8_WAIT_L(0); PG8_MMA(0, 1, At, B1); PG8_BAR;
            PG8_LDA(At, 0, 1); PG8_STAGEA(PG8_SA(0, 0), a2, voffA);
            PG8_BAR; PG8_WAIT_L(0); PG8_MMA(1, 0, At, B0); PG8_BAR; PG8_SCHED;
            PG8_STAGE(PG8_SB(0, 1), b2, voffB1);
            PG8_WAIT_V(6); PG8_BAR; PG8_MMA(1, 1, At, B1); PG8_BAR;
            PG8_LDB(B0, 1, 0); PG8_SCHED; PG8_LDA(At, 1, 0); PG8_STAGEA(PG8_SA(0, 1), a2 + hstepA, voffA);
            PG8_WAIT_L(8); PG8_BAR; PG8_WAIT_L(0); PG8_MMA(0, 0, At, B0); PG8_BAR; PG8_SCHED;
            PG8_LDB(B1, 1, 1); PG8_STAGE(PG8_SB(1, 0), b3, voffB);
            PG8_BAR; PG8_WAIT_L(0); PG8_MMA(0, 1, At, B1); PG8_BAR;
            PG8_LDA(At, 1, 1); PG8_STAGEA(PG8_SA(1, 0), a3, voffA);
            PG8_BAR; PG8_WAIT_L(0); PG8_MMA(1, 0, At, B0); PG8_BAR; PG8_SCHED;
            PG8_STAGE(PG8_SB(1, 1), b3, voffB1);
            PG8_WAIT_V(6); PG8_BAR; PG8_MMA(1, 1, At, B1); PG8_BAR;
            }
        }
        if constexpr (ALIGN_EPI) { if (wr == 0) PG8_BAR; }
        if (!NOEPI) E(acc, cur, wr, wc, fr, fq);
        else { float sink = 0.f; _Pragma("unroll") for (int a = 0; a < 2; ++a) _Pragma("unroll") for (int b = 0; b < 2; ++b) _Pragma("unroll") for (int m = 0; m < 4; ++m) _Pragma("unroll") for (int n = 0; n < 2; ++n) sink += acc[a][b][m][n][0] + acc[a][b][m][n][1] + acc[a][b][m][n][2] + acc[a][b][m][n][3]; if (sink == 12345.678f) *(float*)g.A = sink; }
        if (!has_next) break;
#pragma unroll
        for (int a = 0; a < 2; ++a)
#pragma unroll
            for (int b = 0; b < 2; ++b)
#pragma unroll
                for (int m = 0; m < 4; ++m)
#pragma unroll
                    for (int n = 0; n < 2; ++n) acc[a][b][m][n] = (f32x4){0.f, 0.f, 0.f, 0.f};
        cur = nxt; cA = nA; cB = nB; ++ui;
        if constexpr (ALIGN_EPI) { if (wr == 1) PG8_BAR; }
    }
    PG8_WAIT_V(0);
    if constexpr (!ALIGN_EPI) { if (wr == 0) PG8_BAR; }
    PG8_BAR;
#undef PG8_SA
#undef PG8_SB
#undef PG8_STAGE
#undef PG8_STAGEA
#undef PG8_LDA
#undef PG8_LDB
#undef PG8_MMA
#undef PG8_WAIT_V
#undef PG8_WAIT_L
#undef PG8_BAR
#undef PG8_SCHED
#undef PG8_AROW
}
}

__device__ __forceinline__ void p0_transpose_item(const float* W, int K, int N, bf16_t* WT, int drow0, int scol0, int k0, LAS float* scr, int lane) {
    if (scol0 >= 0) {
#pragma unroll 8
        for (int i = 0; i < 32; ++i) { const int kk = 2 * i + (lane >> 5); scr[kk * 33 + (lane & 31)] = W[(size_t)(k0 + kk) * N + scol0 + (lane & 31)]; }
    } else {
#pragma unroll 8
        for (int i = 0; i < 32; ++i) { const int kk = 2 * i + (lane >> 5); scr[kk * 33 + (lane & 31)] = 0.f; }
    }
    asm volatile("s_waitcnt lgkmcnt(0)" ::: "memory");
    const int c = lane & 7;
#pragma unroll
    for (int j = 0; j < 4; ++j) { const int n = (lane >> 3) + 8 * j; const LAS float* s = scr + (8 * c) * 33 + n;
        u32x4 o; o.x = cvt_pk_bf16(s[0 * 33], s[1 * 33]); o.y = cvt_pk_bf16(s[2 * 33], s[3 * 33]); o.z = cvt_pk_bf16(s[4 * 33], s[5 * 33]); o.w = cvt_pk_bf16(s[6 * 33], s[7 * 33]);
        *(u32x4*)(WT + (size_t)(drow0 + n) * K + k0 + 8 * c) = o; }
    asm volatile("s_waitcnt lgkmcnt(0)" ::: "memory");
}
__device__ __forceinline__ int win_src_col(int n) {
    if (n < 2048) return n;
    if (n < 4096) return 6144 + (n - 2048);
    if (n < 8192) { const int m = n - 4096, t = m >> 8, j = m & 255, wc = j >> 6, bj = (j >> 5) & 1; return (bj ? 4096 : 2048) + 128 * t + 32 * wc; }
    if (n < NIN) return n;
    return -1;
}
__device__ __forceinline__ void phase0(const Params& P, LAS unsigned char* lds) {
    const int tid = opaque_tid(), lane = tid & 63, wave = tid >> 6;
    LAS float* scr = (LAS float*)(lds + wave * 16384);
    const int gw = blockIdx.x * 8 + wave, NGW = gridDim.x * 8;
    bf16_t* WinT = (bf16_t*)(P.ws + WS_TAIL); bf16_t* WoutT = (bf16_t*)(P.ws + WS_WOUT); bf16_t* W1T = (bf16_t*)(P.ws + WS_W1); bf16_t* W2T = (bf16_t*)(P.ws + WS_W2);
    constexpr int I_IN = (DM / 64) * (NPAD / 32), I_OUT = (DMIX / 64) * (DM / 32), I_1 = (DM / 64) * (DFF / 32), I_2 = (DFF / 64) * (DM / 32);
    for (int it = gw; it < I_IN + I_OUT + I_1 + I_2; it += NGW) {
        int r = it;
        if (r < I_IN) { const int nb = r % (NPAD / 32), kb = r / (NPAD / 32); p0_transpose_item(P.w_in, DM, NIN, WinT, nb * 32, win_src_col(nb * 32), kb * 64, scr, lane); continue; } r -= I_IN;
        if (r < I_OUT) { const int nb = r % (DM / 32), kb = r / (DM / 32); p0_transpose_item(P.w_out, DMIX, DM, WoutT, nb * 32, nb * 32, kb * 64, scr, lane); continue; } r -= I_OUT;
        if (r < I_1) { const int nb = r % (DFF / 32), kb = r / (DFF / 32); p0_transpose_item(P.w1, DM, DFF, W1T, nb * 32, nb * 32, kb * 64, scr, lane); continue; } r -= I_1;
        { const int nb = r % (DM / 32), kb = r / (DM / 32); p0_transpose_item(P.w2, DFF, DM, W2T, nb * 32, nb * 32, kb * 64, scr, lane); }
    }
    bf16_t* HN = (bf16_t*)P.out;
    for (int r = gw; r < TP; r += NGW) {
        const int b = r / LP, p = r % LP;
        u32x2* o8 = (u32x2*)(HN + (size_t)r * DM) + lane;
        if (p < 112) {
#pragma unroll
            for (int j = 0; j < 8; ++j) o8[64 * j] = (u32x2){0u, 0u};
            continue;
        }
        const float* src = (p < 128) ? P.meta + (size_t)(p - 112) * DM : P.x + ((size_t)b * SEQ + (p - 128)) * DM;
        const f32x4* xr = (const f32x4*)src + lane; const f32x4* gr = (const f32x4*)P.g_premix + lane;
        f32x4 v[8]; float s = 0.f;
#pragma unroll
        for (int j = 0; j < 8; ++j) { v[j] = __builtin_nontemporal_load(xr + 64 * j); s += (v[j].x * v[j].x + v[j].y * v[j].y) + (v[j].z * v[j].z + v[j].w * v[j].w); }
        const float rs = rsqrtf(wave_sum(s) * (1.f / DM) + EPS);
#pragma unroll
        for (int j = 0; j < 8; ++j) { const f32x4 gg = gr[64 * j]; o8[64 * j] = (u32x2){cvt_pk_bf16(v[j].x * rs * gg.x, v[j].y * rs * gg.y), cvt_pk_bf16(v[j].z * rs * gg.z, v[j].w * rs * gg.w)}; }
    }
}

constexpr int LROW = 272;
constexpr int L_CS = 0, L_DT = 2048, L_WG = 4096, L_TOT = 6144, L_X = 8192, L_B = L_X + 256 * LROW, L_P0 = L_B + 128 * LROW, L_P1 = L_P0 + 64 * LROW;
static_assert(L_P1 + 64 * LROW <= LDS_SSD, "lds");

__device__ __forceinline__ bf16_t ssd_dt_load(const bf16_t* proj, size_t R0, int g) {
    const int tid = opaque_tid(), hh = tid >> 7, l = tid & 127, head = 4 * g + hh;
    return proj[(R0 + l) * LDP + COL_DT + head];
}
__device__ __forceinline__ void ssd_dt_prologue(const Params& P, LAS unsigned char* lds, bf16_t rawb, int g) {
    const int tid = opaque_tid(), lane = tid & 63, wid = tid >> 6, hh = tid >> 7, l = tid & 127, head = 4 * g + hh;
    LAS float* cs = (LAS float*)(lds + L_CS); LAS float* dt = (LAS float*)(lds + L_DT); LAS float* tot = (LAS float*)(lds + L_TOT);
    const float raw = bf2f(rawb);
    const float dtv = softplus_f(raw + P.dtb[head]);
    float s = -__expf(P.alog[head]) * dtv;
#pragma unroll
    for (int o = 1; o < 64; o <<= 1) { const float t = __shfl_up(s, o); if (lane >= o) s += t; }
    if (lane == 63) tot[wid] = s;
    __syncthreads();
    if (wid & 1) s += tot[wid - 1];
    cs[hh * 128 + l] = s; dt[hh * 128 + l] = dtv;
    __syncthreads();
}

struct XRows { unsigned w[35]; };
__device__ __forceinline__ void ssd_conv_x_load(XRows& xr, const bf16_t* proj, size_t R0, int c, int g) {
    const int tid = opaque_tid(), cp = tid & 127, run = tid >> 7;
    const bf16_t* src = proj + COL_X + 256 * g + 2 * cp;
    const int l0 = 32 * run;
#pragma unroll
    for (int k = 0; k < 35; ++k) { const int li = l0 - 3 + k; xr.w[k] = (c > 0 || li >= 0) ? *(const unsigned*)(src + (size_t)((long)R0 + li) * LDP) : 0u; }
}
template <bool SCALE>
__device__ __forceinline__ void ssd_conv_x(const Params& P, LAS unsigned char* lds, const XRows& xr, int g) {
    const int tid = opaque_tid(), cp = tid & 127, run = tid >> 7, ch = 2 * cp, hh = cp >> 5;
    const int xc = 256 * g + ch;
    float w0[4], w1[4];
#pragma unroll
    for (int k = 0; k < 4; ++k) { w0[k] = P.cw[k * 4096 + xc]; w1[k] = P.cw[k * 4096 + xc + 1]; }
    const float b0 = P.cb[xc], b1 = P.cb[xc + 1];
    const LAS float* wg = (const LAS float*)(lds + L_WG) + hh * 128;
    const int l0 = 32 * run;
#pragma unroll
    for (int i = 0; i < 32; i += 8) {
        float o0[8], o1[8];
#pragma unroll
        for (int j = 0; j < 8; ++j) {
            const int t = i + j;
            float y0 = b0 + w0[0] * bf_lo(xr.w[t]) + w0[1] * bf_lo(xr.w[t + 1]) + w0[2] * bf_lo(xr.w[t + 2]) + w0[3] * bf_lo(xr.w[t + 3]);
            float y1 = b1 + w1[0] * bf_hi(xr.w[t]) + w1[1] * bf_hi(xr.w[t + 1]) + w1[2] * bf_hi(xr.w[t + 2]) + w1[3] * bf_hi(xr.w[t + 3]);
            y0 = silu_f(y0); y1 = silu_f(y1);
            if (SCALE) { const float sc = wg[l0 + t]; y0 *= sc; y1 *= sc; }
            o0[j] = y0; o1[j] = y1;
        }
        u32x4 q0, q1;
        q0.x = cvt_pk_bf16(o0[0], o0[1]); q0.y = cvt_pk_bf16(o0[2], o0[3]); q0.z = cvt_pk_bf16(o0[4], o0[5]); q0.w = cvt_pk_bf16(o0[6], o0[7]);
        q1.x = cvt_pk_bf16(o1[0], o1[1]); q1.y = cvt_pk_bf16(o1[2], o1[3]); q1.z = cvt_pk_bf16(o1[4], o1[5]); q1.w = cvt_pk_bf16(o1[6], o1[7]);
        *(LAS u32x4*)(lds + L_X + ch * LROW + (l0 + i) * 2) = q0;
        *(LAS u32x4*)(lds + L_X + (ch + 1) * LROW + (l0 + i) * 2) = q1;
    }
}

__device__ __forceinline__ void ssd_states_unit(const Params& P, LAS unsigned char* lds, int unit) {
    const int g = unit & 7, c = (unit >> 3) & 127, b = unit >> 10;
    const int tid = opaque_tid(), lane = tid & 63, wid = tid >> 6, fr = lane & 15, fq = lane >> 4;
    const bf16_t* proj = (const bf16_t*)(P.ws + WS_PROJ);
    const size_t R0 = (size_t)b * LP + (size_t)c * 128;
    const bf16_t rawdt = ssd_dt_load(proj, R0, g);
    XRows xr; ssd_conv_x_load(xr, proj, R0, c, g);
    unsigned bwv[19];
    {
        const int cp = tid & 63, run = tid >> 6, l0 = 16 * run;
        const bf16_t* src = proj + COL_B + 128 * g + 2 * cp;
#pragma unroll
        for (int k = 0; k < 19; ++k) { const int li = l0 - 3 + k; bwv[k] = (c > 0 || li >= 0) ? *(const unsigned*)(src + (size_t)((long)R0 + li) * LDP) : 0u; }
    }
    ssd_dt_prologue(P, lds, rawdt, g);
    {
        const int hh = tid >> 7, l = tid & 127;
        const LAS float* cs = (const LAS float*)(lds + L_CS) + hh * 128; const LAS float* dt = (const LAS float*)(lds + L_DT) + hh * 128;
        const float ce = cs[127];
        float w = dt[l] * __expf(ce - cs[l]);
        if (c == 0 && l < 112) w = 0.f;
        ((LAS float*)(lds + L_WG))[hh * 128 + l] = w;
        if (l == 127) ((float*)(P.ws + WS_DEC))[(b * 128 + c) * 32 + 4 * g + hh] = __expf(ce);
    }
    __syncthreads();
    ssd_conv_x<true>(P, lds, xr, g);
    {
        const int cp = tid & 63, run = tid >> 6, n0 = 2 * cp, bc = 2048 + 128 * g + n0;
        float w0[4], w1[4];
#pragma unroll
        for (int k = 0; k < 4; ++k) { w0[k] = P.cw[k * 4096 + bc]; w1[k] = P.cw[k * 4096 + bc + 1]; }
        const float b0 = P.cb[bc], b1 = P.cb[bc + 1];
        const int l0 = 16 * run;
#pragma unroll
        for (int i = 0; i < 16; i += 8) {
            float o0[8], o1[8];
#pragma unroll
            for (int j = 0; j < 8; ++j) {
                const int t = i + j;
                o0[j] = silu_f(b0 + w0[0] * bf_lo(bwv[t]) + w0[1] * bf_lo(bwv[t + 1]) + w0[2] * bf_lo(bwv[t + 2]) + w0[3] * bf_lo(bwv[t + 3]));
                o1[j] = silu_f(b1 + w1[0] * bf_hi(bwv[t]) + w1[1] * bf_hi(bwv[t + 1]) + w1[2] * bf_hi(bwv[t + 2]) + w1[3] * bf_hi(bwv[t + 3]));
            }
            u32x4 q0, q1;
            q0.x = cvt_pk_bf16(o0[0], o0[1]); q0.y = cvt_pk_bf16(o0[2], o0[3]); q0.z = cvt_pk_bf16(o0[4], o0[5]); q0.w = cvt_pk_bf16(o0[6], o0[7]);
            q1.x = cvt_pk_bf16(o1[0], o1[1]); q1.y = cvt_pk_bf16(o1[2], o1[3]); q1.z = cvt_pk_bf16(o1[4], o1[5]); q1.w = cvt_pk_bf16(o1[6], o1[7]);
            *(LAS u32x4*)(lds + L_B + n0 * LROW + (l0 + i) * 2) = q0;
            *(LAS u32x4*)(lds + L_B + (n0 + 1) * LROW + (l0 + i) * 2) = q1;
        }
    }
    __syncthreads();
    f32x4 acc[2][8];
#pragma unroll
    for (int i = 0; i < 2; ++i)
#pragma unroll
        for (int nt = 0; nt < 8; ++nt) acc[i][nt] = (f32x4){0.f, 0.f, 0.f, 0.f};
#pragma unroll
    for (int ks = 0; ks < 4; ++ks) {
        bf16x8 xf[2];
#pragma unroll
        for (int i = 0; i < 2; ++i) xf[i] = *(const LAS bf16x8*)(lds + L_X + (16 * (2 * wid + i) + fr) * LROW + (32 * ks + 8 * fq) * 2);
#pragma unroll
        for (int nt = 0; nt < 8; ++nt) {
            const bf16x8 bfr = *(const LAS bf16x8*)(lds + L_B + (16 * nt + fr) * LROW + (32 * ks + 8 * fq) * 2);
#pragma unroll
            for (int i = 0; i < 2; ++i) acc[i][nt] = __builtin_amdgcn_mfma_f32_16x16x32_bf16(bfr, xf[i], acc[i][nt], 0, 0, 0);
        }
    }
    __syncthreads();
    {
        LAS unsigned char* stg = lds + L_X + wid * (32 * LROW);
#pragma unroll
        for (int i = 0; i < 2; ++i)
#pragma unroll
            for (int nt = 0; nt < 8; ++nt) { const f32x4 a = acc[i][nt]; *(LAS u32x2*)(stg + (16 * i + fr) * LROW + (16 * nt + 4 * fq) * 2) = (u32x2){pk_bf16_sw(a.x, a.y), pk_bf16_sw(a.z, a.w)}; }
        bf16_t* Sg = (bf16_t*)(P.ws + WS_TAIL) + ((size_t)(b * 128 + c) * 32 + 4 * g + (wid >> 1)) * 8192 + (size_t)((32 * wid) & 63) * 128;
        const int rsub = lane >> 4, ck = lane & 15;
#pragma unroll
        for (int j = 0; j < 8; ++j) { const u32x4 v = *(const LAS u32x4*)(stg + (4 * j + rsub) * LROW + ck * 16); *(u32x4*)(Sg + (4 * j + rsub) * 128 + ck * 8) = v; }
    }
}

__device__ __forceinline__ void shortconv_task(const Params& P, int task, int lane) {
    bf16_t* proj = (bf16_t*)(P.ws + WS_PROJ);
    const int q = task & 3, run = task >> 2, m0 = run * 32;
    const size_t row0 = (size_t)m0 + 128 + 128 * (m0 >> 14);
    const int ch0 = 512 * q + 8 * lane;
    float w[3][8], gn[8];
#pragma unroll
    for (int k = 0; k < 3; ++k) { const f32x4 a = *(const f32x4*)(P.scw + k * 2048 + ch0), bq = *(const f32x4*)(P.scw + k * 2048 + ch0 + 4);
        w[k][0] = a.x; w[k][1] = a.y; w[k][2] = a.z; w[k][3] = a.w; w[k][4] = bq.x; w[k][5] = bq.y; w[k][6] = bq.z; w[k][7] = bq.w; }
    { const f32x4 a = *(const f32x4*)(P.cng + ch0), bq = *(const f32x4*)(P.cng + ch0 + 4); gn[0] = a.x; gn[1] = a.y; gn[2] = a.z; gn[3] = a.w; gn[4] = bq.x; gn[5] = bq.y; gn[6] = bq.z; gn[7] = bq.w; }
    float u1[8], u2[8];
#pragma unroll
    for (int k = 0; k < 2; ++k) {
        const size_t r = row0 - 2 + k;
        const u32x4 uu = *(const u32x4*)(proj + r * LDP + COL_U + ch0);
        float* dst = (k == 0) ? u2 : u1;
        dst[0] = bf_lo(uu.x); dst[1] = bf_hi(uu.x); dst[2] = bf_lo(uu.y); dst[3] = bf_hi(uu.y); dst[4] = bf_lo(uu.z); dst[5] = bf_hi(uu.z); dst[6] = bf_lo(uu.w); dst[7] = bf_hi(uu.w);
    }
#pragma unroll 4
    for (int t = 0; t < 32; ++t) {
        const size_t r = row0 + t;
        const u32x4 uu = *(const u32x4*)(proj + r * LDP + COL_U + ch0), gb = *(const u32x4*)(proj + r * LDP + COL_GB + ch0);
        float u0[8], gbf[8], y[8];
        u0[0] = bf_lo(uu.x); u0[1] = bf_hi(uu.x); u0[2] = bf_lo(uu.y); u0[3] = bf_hi(uu.y); u0[4] = bf_lo(uu.z); u0[5] = bf_hi(uu.z); u0[6] = bf_lo(uu.w); u0[7] = bf_hi(uu.w);
        gbf[0] = bf_lo(gb.x); gbf[1] = bf_hi(gb.x); gbf[2] = bf_lo(gb.y); gbf[3] = bf_hi(gb.y); gbf[4] = bf_lo(gb.z); gbf[5] = bf_hi(gb.z); gbf[6] = bf_lo(gb.w); gbf[7] = bf_hi(gb.w);
        float ss = 0.f;
#pragma unroll
        for (int j = 0; j < 8; ++j) { y[j] = gbf[j] * (w[2][j] * u0[j] + w[1][j] * u1[j] + w[0][j] * u2[j]); ss += y[j] * y[j]; u2[j] = u1[j]; u1[j] = u0[j]; }
        ss += __shfl_xor(ss, 1); ss += __shfl_xor(ss, 2); ss += __shfl_xor(ss, 4); ss += __shfl_xor(ss, 8);
        const float rs = rsqrtf(ss * (1.f / 128.f) + EPS);
        u32x4 o; o.x = cvt_pk_bf16(y[0] * rs * gn[0], y[1] * rs * gn[1]); o.y = cvt_pk_bf16(y[2] * rs * gn[2], y[3] * rs * gn[3]);
        o.z = cvt_pk_bf16(y[4] * rs * gn[4], y[5] * rs * gn[5]); o.w = cvt_pk_bf16(y[6] * rs * gn[6], y[7] * rs * gn[7]);
        *(u32x4*)(proj + r * LDP + COL_GB + ch0) = o;
    }
}

__device__ __forceinline__ void scan_phase(const Params& P) {
    const float* dec = (const float*)(P.ws + WS_DEC); bf16_t* prev = (bf16_t*)(P.ws + WS_TAIL);
    for (int gid = blockIdx.x * 512 + threadIdx.x; gid < NBATCH * 32 * 64 * 32; gid += gridDim.x * 512) {
        const int n4 = gid & 31, p = (gid >> 5) & 63, h = (gid >> 11) & 31, b = gid >> 16;
        f32x4 st = (f32x4){0.f, 0.f, 0.f, 0.f};
        size_t idx = ((size_t)(b * 128) * 32 + h) * 8192 + p * 128 + 4 * n4;
        const float* dp = dec + (b * 128) * 32 + h;
#pragma unroll 8
        for (int c = 0; c < 128; ++c) {
            const u32x2 sw = *(const u32x2*)(prev + idx); const f32x4 sv = (f32x4){bf_lo(sw.x), bf_hi(sw.x), bf_lo(sw.y), bf_hi(sw.y)}; const float d = dp[c * 32];
            st = st * d + sv;
            *(u32x2*)(prev + idx) = (u32x2){cvt_pk_bf16(st.x, st.y), cvt_pk_bf16(st.z, st.w)};
            idx += (size_t)32 * 8192;
        }
    }
}

__device__ __forceinline__ void ssd_out_unit(const Params& P, LAS unsigned char* lds, int unit) {
    const int g = unit & 7, c = ((unit >> 3) & 127) + 1, b = unit >> 10;
    const int tid = opaque_tid(), lane = tid & 63, wid = tid >> 6, fr = lane & 15, fq = lane >> 4;
    bf16_t* proj = (bf16_t*)(P.ws + WS_PROJ);
    const size_t R0 = (size_t)b * LP + (size_t)c * 128;
    const bf16_t* prevg = (const bf16_t*)(P.ws + WS_TAIL) + ((size_t)(b * 128 + (c - 1)) * 32 + 4 * g) * 8192;
    u32x4 pf[2];
#pragma unroll
    for (int i = 0; i < 2; ++i) pf[i] = *(const u32x4*)(prevg + (size_t)(tid + 512 * i) * 8);
    const bf16_t rawdt = ssd_dt_load(proj, R0, g);
    XRows xr; ssd_conv_x_load(xr, proj, R0, c, g);
    u32x4 rw[7];
    {   const int c8 = tid & 15, run = tid >> 4, l0 = 4 * run;
        const bf16_t* src = proj + COL_B + 128 * g + 8 * c8;
#pragma unroll
        for (int k = 0; k < 7; ++k) rw[k] = *(const u32x4*)(src + (R0 + l0 - 3 + k) * LDP);
    }
    const int l = 16 * wid + fr;
    u32x4 crow[4][4];
#pragma unroll
    for (int ks = 0; ks < 4; ++ks)
#pragma unroll
        for (int k = 0; k < 4; ++k) crow[ks][k] = *(const u32x4*)(proj + COL_C + 128 * g + 32 * ks + 8 * fq + (R0 + l - 3 + k) * LDP);
    ssd_dt_prologue(P, lds, rawdt, g);
    ssd_conv_x<false>(P, lds, xr, g);
    {
        const int c8 = tid & 15, run = tid >> 4, n0 = 8 * c8, bc = 2048 + 128 * g + n0, l0 = 4 * run;
        float w[4][8], bb[8];
#pragma unroll
        for (int k = 0; k < 4; ++k) { const f32x4 a = *(const f32x4*)(P.cw + k * 4096 + bc), a2 = *(const f32x4*)(P.cw + k * 4096 + bc + 4);
            w[k][0] = a.x; w[k][1] = a.y; w[k][2] = a.z; w[k][3] = a.w; w[k][4] = a2.x; w[k][5] = a2.y; w[k][6] = a2.z; w[k][7] = a2.w; }
        { const f32x4 a = *(const f32x4*)(P.cb + bc), a2 = *(const f32x4*)(P.cb + bc + 4); bb[0] = a.x; bb[1] = a.y; bb[2] = a.z; bb[3] = a.w; bb[4] = a2.x; bb[5] = a2.y; bb[6] = a2.z; bb[7] = a2.w; }
#pragma unroll
        for (int t = 0; t < 4; ++t) {
            float y[8];
#pragma unroll
            for (int j = 0; j < 8; ++j) y[j] = bb[j];
#pragma unroll
            for (int k = 0; k < 4; ++k) { const u32x4 q = rw[t + k];
                y[0] += w[k][0] * bf_lo(q.x); y[1] += w[k][1] * bf_hi(q.x); y[2] += w[k][2] * bf_lo(q.y); y[3] += w[k][3] * bf_hi(q.y);
                y[4] += w[k][4] * bf_lo(q.z); y[5] += w[k][5] * bf_hi(q.z); y[6] += w[k][6] * bf_lo(q.w); y[7] += w[k][7] * bf_hi(q.w); }
#pragma unroll
            for (int j = 0; j < 8; ++j) y[j] = silu_f(y[j]);
            u32x4 o; o.x = cvt_pk_bf16(y[0], y[1]); o.y = cvt_pk_bf16(y[2], y[3]); o.z = cvt_pk_bf16(y[4], y[5]); o.w = cvt_pk_bf16(y[6], y[7]);
            *(LAS u32x4*)(lds + L_B + (l0 + t) * LROW + n0 * 2) = o;
        }
    }
    bf16x8 Cf[4];
#pragma unroll
    for (int ks = 0; ks < 4; ++ks) {
        const int n0 = 32 * ks + 8 * fq, cc = 3072 + 128 * g + n0;
        float y[8];
        { const f32x4 a = *(const f32x4*)(P.cb + cc), a2 = *(const f32x4*)(P.cb + cc + 4); y[0] = a.x; y[1] = a.y; y[2] = a.z; y[3] = a.w; y[4] = a2.x; y[5] = a2.y; y[6] = a2.z; y[7] = a2.w; }
#pragma unroll
        for (int k = 0; k < 4; ++k) {
            const u32x4 q = crow[ks][k];
            const f32x4 a = *(const f32x4*)(P.cw + k * 4096 + cc), a2 = *(const f32x4*)(P.cw + k * 4096 + cc + 4);
            y[0] += a.x * bf_lo(q.x); y[1] += a.y * bf_hi(q.x); y[2] += a.z * bf_lo(q.y); y[3] += a.w * bf_hi(q.y);
            y[4] += a2.x * bf_lo(q.z); y[5] += a2.y * bf_hi(q.z); y[6] += a2.z * bf_lo(q.w); y[7] += a2.w * bf_hi(q.w);
        }
#pragma unroll
        for (int j = 0; j < 8; ++j) y[j] = silu_f(y[j]);
        u32x4 o; o.x = cvt_pk_bf16(y[0], y[1]); o.y = cvt_pk_bf16(y[2], y[3]); o.z = cvt_pk_bf16(y[4], y[5]); o.w = cvt_pk_bf16(y[6], y[7]);
        Cf[ks] = __builtin_bit_cast(bf16x8, o);
        asm volatile("" ::: "memory");
    }
#pragma unroll
    for (int i = 0; i < 2; ++i) { const int e = tid + 512 * i; *(LAS u32x4*)(lds + L_P0 + (e >> 4) * LROW + (e & 15) * 16) = pf[i]; }
    __syncthreads();
    f32x4 cbt[8];
    const int wu = __builtin_amdgcn_readfirstlane(wid);
#pragma unroll
    for (int T = 0; T < 8; ++T) { cbt[T] = (f32x4){0.f, 0.f, 0.f, 0.f};
        if (T <= wu)
#pragma unroll
        for (int ks = 0; ks < 4; ++ks) { const bf16x8 af = *(const LAS bf16x8*)(lds + L_B + (16 * T + fr) * LROW + (32 * ks + 8 * fq) * 2);
            cbt[T] = __builtin_amdgcn_mfma_f32_16x16x32_bf16(af, Cf[ks], cbt[T], 0, 0, 0); } }
    u32x2 yr0[4], yr1[4], yr2[4], yr3[4]; float ssq = 0.f;
#pragma unroll
    for (int pt = 0; pt < 4; ++pt) { yr0[pt] = yr1[pt] = yr2[pt] = yr3[pt] = (u32x2){0u, 0u}; }
#pragma unroll 1
    for (int hh = 0; hh < 4; ++hh) {
        if (hh < 3) {
#pragma unroll
            for (int i = 0; i < 2; ++i) pf[i] = *(const u32x4*)(prevg + (size_t)(hh + 1) * 8192 + (size_t)(tid + 512 * i) * 8);
        }
        const LAS float* cs = (const LAS float*)(lds + L_CS) + hh * 128; const LAS float* dt = (const LAS float*)(lds + L_DT) + hh * 128;
        const float csl = cs[l], Dh = P.dsk[4 * g + hh];
        f32x4 yd[4], yo[4];
#pragma unroll
        for (int pt = 0; pt < 4; ++pt) { yd[pt] = (f32x4){0.f, 0.f, 0.f, 0.f}; yo[pt] = (f32x4){0.f, 0.f, 0.f, 0.f}; }
#pragma unroll
        for (int q = 0; q < 4; ++q) if (2 * q <= wu) {
            float pv[8];
#pragma unroll
            for (int hf = 0; hf < 2; ++hf) {
                const int T = 2 * q + hf, s0 = 16 * T + 4 * fq;
                const f32x4 c4 = *(const LAS f32x4*)(cs + s0), d4 = *(const LAS f32x4*)(dt + s0);
#pragma unroll
                for (int r = 0; r < 4; ++r) {
                    const int s = s0 + r;
                    const float e = (s <= l) ? __expf(fminf(csl - c4[r], 0.f)) * d4[r] : 0.f;
                    float v = cbt[T][r] * e; if (s == l) v += Dh;
                    pv[hf * 4 + r] = v;
                }
            }
            u32x4 o; o.x = cvt_pk_bf16(pv[0], pv[1]); o.y = cvt_pk_bf16(pv[2], pv[3]); o.z = cvt_pk_bf16(pv[4], pv[5]); o.w = cvt_pk_bf16(pv[6], pv[7]);
            const bf16x8 pfr = __builtin_bit_cast(bf16x8, o);
#pragma unroll
            for (int pt = 0; pt < 4; ++pt) {
                const LAS unsigned char* xr = lds + L_X + (64 * hh + 16 * pt + fr) * LROW + (32 * q + 4 * fq) * 2;
                const u32x2 lo = *(const LAS u32x2*)xr, hi = *(const LAS u32x2*)(xr + 32);
                const u32x4 xx = (u32x4){lo.x, lo.y, hi.x, hi.y};
                yd[pt] = __builtin_amdgcn_mfma_f32_16x16x32_bf16(__builtin_bit_cast(bf16x8, xx), pfr, yd[pt], 0, 0, 0);
            }
        }
        const int pbuf = (hh & 1) ? L_P1 : L_P0;
#pragma unroll
        for (int ks = 0; ks < 4; ++ks)
#pragma unroll
            for (int pt = 0; pt < 4; ++pt) { const bf16x8 pa = *(const LAS bf16x8*)(lds + pbuf + (16 * pt + fr) * LROW + (32 * ks + 8 * fq) * 2);
                yo[pt] = __builtin_amdgcn_mfma_f32_16x16x32_bf16(pa, Cf[ks], yo[pt], 0, 0, 0); }
        const float el = __expf(csl);
#pragma unroll
        for (int pt = 0; pt < 4; ++pt) {
            const f32x4 v = yd[pt] + yo[pt] * el;
            yr3[pt] = yr2[pt]; yr2[pt] = yr1[pt]; yr1[pt] = yr0[pt]; yr0[pt] = (u32x2){cvt_pk_bf16(v.x, v.y), cvt_pk_bf16(v.z, v.w)};
        }
        if (hh < 3) {
            const int nbuf = (hh & 1) ? L_P0 : L_P1;
#pragma unroll
            for (int i = 0; i < 2; ++i) { const int e = tid + 512 * i; *(LAS u32x4*)(lds + nbuf + (e >> 4) * LROW + (e & 15) * 16) = pf[i]; }
        }
        __syncthreads();
    }
    (void)ssq;
    {
        constexpr int YP = 528;
        LAS unsigned char* stg = lds + L_X + wid * (16 * YP);
#pragma unroll
        for (int hh = 0; hh < 4; ++hh)
#pragma unroll
            for (int pt = 0; pt < 4; ++pt) {
                const u32x2 vp = (hh == 0) ? yr3[pt] : (hh == 1) ? yr2[pt] : (hh == 2) ? yr1[pt] : yr0[pt];
                *(LAS u32x2*)(stg + fr * YP + (64 * hh + 16 * pt + 4 * fq) * 2) = vp;
            }
        const int rsub = lane >> 5, c8 = (lane & 31) * 8;
        const f32x4 ga = *(const f32x4*)(P.sng + 256 * g + c8), gb = *(const f32x4*)(P.sng + 256 * g + c8 + 4);
        u32x4 zr[8];
#pragma unroll
        for (int j = 0; j < 8; ++j) zr[j] = *(const u32x4*)(proj + (R0 + 16 * wid + 2 * j + rsub) * LDP + COL_Z + 256 * g + c8);
#pragma unroll
        for (int j = 0; j < 8; ++j) {
            const u32x4 yv = *(const LAS u32x4*)(stg + (2 * j + rsub) * YP + c8 * 2);
            float v[8];
            v[0] = bf_lo(yv.x) * silu_f(bf_lo(zr[j].x)); v[1] = bf_hi(yv.x) * silu_f(bf_hi(zr[j].x)); v[2] = bf_lo(yv.y) * silu_f(bf_lo(zr[j].y)); v[3] = bf_hi(yv.y) * silu_f(bf_hi(zr[j].y));
            v[4] = bf_lo(yv.z) * silu_f(bf_lo(zr[j].z)); v[5] = bf_hi(yv.z) * silu_f(bf_hi(zr[j].z)); v[6] = bf_lo(yv.w) * silu_f(bf_lo(zr[j].w)); v[7] = bf_hi(yv.w) * silu_f(bf_hi(zr[j].w));
            float ss = ((v[0] * v[0] + v[1] * v[1]) + (v[2] * v[2] + v[3] * v[3])) + ((v[4] * v[4] + v[5] * v[5]) + (v[6] * v[6] + v[7] * v[7]));
            ss += __shfl_xor(ss, 1); ss += __shfl_xor(ss, 2); ss += __shfl_xor(ss, 4); ss += __shfl_xor(ss, 8); ss += __shfl_xor(ss, 16);
            const float rs = rsqrtf(ss * (1.f / 256.f) + EPS);
            u32x4 o; o.x = cvt_pk_bf16(v[0] * rs * ga.x, v[1] * rs * ga.y); o.y = cvt_pk_bf16(v[2] * rs * ga.z, v[3] * rs * ga.w);
            o.z = cvt_pk_bf16(v[4] * rs * gb.x, v[5] * rs * gb.y); o.w = cvt_pk_bf16(v[6] * rs * gb.z, v[7] * rs * gb.w);
            *(u32x4*)(proj + (R0 + 16 * wid + 2 * j + rsub) * LDP + COL_Z + 256 * g + c8) = o;
        }
    }
}

__device__ __forceinline__ void post_mix_phase(const Params& P) {
    const int lane = threadIdx.x & 63, gw = blockIdx.x * 8 + (threadIdx.x >> 6), NGW = gridDim.x * 8;
    const bf16_t* MIX = (const bf16_t*)(P.ws + WS_TAIL); bf16_t* H1N = (bf16_t*)P.out;
    for (int r = gw; r < MR; r += NGW) {
        const f32x4* xr = (const f32x4*)(P.x + (size_t)r * DM) + lane; const u32x2* mb = (const u32x2*)(MIX + (size_t)r * DM) + lane;
        const f32x4* g1 = (const f32x4*)P.g_postmix + lane; const f32x4* g2 = (const f32x4*)P.g_premlp + lane;
        f32x4 v[8]; float s = 0.f;
#pragma unroll
        for (int j = 0; j < 8; ++j) { const u32x2 w = mb[64 * j]; v[j] = (f32x4){bf_lo(w.x), bf_hi(w.x), bf_lo(w.y), bf_hi(w.y)}; s += (v[j].x * v[j].x + v[j].y * v[j].y) + (v[j].z * v[j].z + v[j].w * v[j].w); }
        const float rs = rsqrtf(wave_sum(s) * (1.f / DM) + EPS);
        float s2 = 0.f;
#pragma unroll
        for (int j = 0; j < 8; ++j) { const f32x4 xx = __builtin_nontemporal_load(xr + 64 * j), gg = g1[64 * j]; v[j] = xx + v[j] * rs * gg; s2 += (v[j].x * v[j].x + v[j].y * v[j].y) + (v[j].z * v[j].z + v[j].w * v[j].w); }
        const float rs2 = rsqrtf(wave_sum(s2) * (1.f / DM) + EPS);
        u32x2* o8 = (u32x2*)(H1N + (size_t)r * DM) + lane;
#pragma unroll
        for (int j = 0; j < 8; ++j) { const f32x4 gg = g2[64 * j]; o8[64 * j] = (u32x2){cvt_pk_bf16(v[j].x * rs2 * gg.x, v[j].y * rs2 * gg.y), cvt_pk_bf16(v[j].z * rs2 * gg.z, v[j].w * rs2 * gg.w)}; }
    }
}
__device__ __forceinline__ void final_phase(const Params& P) {
    const int lane = threadIdx.x & 63, gw = blockIdx.x * 8 + (threadIdx.x >> 6), NGW = gridDim.x * 8;
    const bf16_t* FF = (const bf16_t*)(P.ws + WS_FF); const bf16_t* MIX = (const bf16_t*)(P.ws + WS_TAIL);
    for (int r = gw; r < MR; r += NGW) {
        f32x4* orow = (f32x4*)(P.out + (size_t)r * DM) + lane; const f32x4* xr = (const f32x4*)(P.x + (size_t)r * DM) + lane;
        const u32x2* fb = (const u32x2*)(FF + (size_t)r * DM) + lane; const u32x2* mb = (const u32x2*)(MIX + (size_t)r * DM) + lane;
        const f32x4* g1 = (const f32x4*)P.g_postmix + lane; const f32x4* g2 = (const f32x4*)P.g_postmlp + lane;
        f32x4 v[8], m[8]; float s = 0.f, sm = 0.f;
#pragma unroll
        for (int j = 0; j < 8; ++j) { const u32x2 w = __builtin_nontemporal_load(fb + 64 * j); v[j] = (f32x4){bf_lo(w.x), bf_hi(w.x), bf_lo(w.y), bf_hi(w.y)}; s += (v[j].x * v[j].x + v[j].y * v[j].y) + (v[j].z * v[j].z + v[j].w * v[j].w);
            const u32x2 q = __builtin_nontemporal_load(mb + 64 * j); m[j] = (f32x4){bf_lo(q.x), bf_hi(q.x), bf_lo(q.y), bf_hi(q.y)}; sm += (m[j].x * m[j].x + m[j].y * m[j].y) + (m[j].z * m[j].z + m[j].w * m[j].w); }
        const float rs = rsqrtf(wave_sum(s) * (1.f / DM) + EPS), rsm = rsqrtf(wave_sum(sm) * (1.f / DM) + EPS);
#pragma unroll
        for (int j = 0; j < 8; ++j) { const f32x4 xx = __builtin_nontemporal_load(xr + 64 * j), ga = g1[64 * j], gb = g2[64 * j]; __builtin_nontemporal_store((xx + m[j] * rsm * ga) + v[j] * rs * gb, orow + 64 * j); }
    }
}

#define XB_TMO      128
#define XB_XCNT(j)  (256  + 64 * (j))
#define XB_XSUB(j)  (1280 + 64 * (j))
#define XB_XGEN(j)  (2304 + 64 * (j))
#define XB_TOP      3328
#define XB_TOPGEN   3392
#define XCD_BAR_WORDS 3456
#define XB_SPIN_CAP (1u << 18)
__device__ __forceinline__ unsigned xb_ld(unsigned* p)              { return __hip_atomic_load(p, __ATOMIC_RELAXED, __HIP_MEMORY_SCOPE_AGENT); }
__device__ __forceinline__ unsigned xb_add(unsigned* p, unsigned v) { return __hip_atomic_fetch_add(p, v, __ATOMIC_RELAXED, __HIP_MEMORY_SCOPE_AGENT); }
__device__ __forceinline__ unsigned xb_xcc_id() { return (unsigned)__builtin_amdgcn_s_getreg((3 << 11) | 20) & 0xFu; }
#define XB_SPIN(cond, bar) do { unsigned _sp = 0; while (cond) { __builtin_amdgcn_s_sleep(1); \
    if ((++_sp & 255u) == 0u) { if (xb_ld(&(bar)[XB_TMO])) break; if (_sp > XB_SPIN_CAP) { atomicAdd(&(bar)[XB_TMO], 1u); break; } } } } while (0)
struct XcdBarrier { unsigned* bar; unsigned x; volatile LAS unsigned* st; };
__device__ __forceinline__ XcdBarrier xcd_barrier_post(unsigned* bar, volatile LAS unsigned* st) {
    XcdBarrier b; b.bar = bar; b.x = xb_xcc_id(); b.st = st;
    if (threadIdx.x == 0) (void)xb_add(&bar[XB_XCNT(b.x)], 1u);
    return b;
}
__device__ __forceinline__ void xcd_barrier_complete(unsigned* bar, unsigned x, unsigned& nloc, unsigned& nx) {
    const unsigned G = gridDim.x * gridDim.y * gridDim.z;
    unsigned sum, cnt, mine, sp = 0u;
    for (;;) {
        sum = 0u; cnt = 0u; mine = 0u;
#pragma unroll
        for (unsigned j = 0; j < 16; ++j) { const unsigned c = xb_ld(&bar[XB_XCNT(j)]); sum += c; cnt += (c > 0u) ? 1u : 0u; mine = (j == x) ? c : mine; }
        if (sum == G) break;
        __builtin_amdgcn_s_sleep(1);
        if ((++sp & 255u) == 0u) { if (xb_ld(&bar[XB_TMO])) break; if (sp > XB_SPIN_CAP) { atomicAdd(&bar[XB_TMO], 1u); break; } }
    }
    nloc = mine > 0u ? mine : 1u; nx = cnt > 0u ? cnt : 1u;
}
__device__ __forceinline__ void xcd_barrier(const XcdBarrier& b) {
    asm volatile("s_waitcnt vmcnt(0)" ::: "memory");
    __syncthreads();
    if (threadIdx.x == 0) {
        unsigned* bar = b.bar;
        __builtin_amdgcn_s_waitcnt(0);
        unsigned nloc = b.st[0], nx = b.st[1];
        if (nloc == 0u) { xcd_barrier_complete(bar, b.x, nloc, nx); b.st[0] = nloc; b.st[1] = nx; }
        const unsigned old = xb_add(&bar[XB_XSUB(b.x)], 1u);
        const unsigned gen = old / nloc;
        if (old + 1u == (gen + 1u) * nloc) {
            __builtin_amdgcn_fence(__ATOMIC_RELEASE, "agent");
            asm volatile("s_waitcnt vmcnt(0)" ::: "memory");
            const unsigned og = xb_add(&bar[XB_TOP], 1u);
            const unsigned tg = og / nx;
            if (og + 1u == (tg + 1u) * nx) xb_add(&bar[XB_TOPGEN], 1u);
            else XB_SPIN(xb_ld(&bar[XB_TOPGEN]) == tg, bar);
            __builtin_amdgcn_fence(__ATOMIC_ACQUIRE, "agent");
            xb_add(&bar[XB_XGEN(b.x)], 1u);
            asm volatile("s_waitcnt vmcnt(0)" ::: "memory");
        } else {
            XB_SPIN(xb_ld(&bar[XB_XGEN(b.x)]) == gen, bar);
            __builtin_amdgcn_fence(__ATOMIC_ACQUIRE, "agent");
            asm volatile("s_waitcnt vmcnt(0)" ::: "memory");
        }
    }
    __syncthreads();
}

extern __shared__ __attribute__((aligned(16))) unsigned char dyn_lds[];

__global__ void __launch_bounds__(512) hymba_fwd(Params P) {
    cg::grid_group grid = cg::this_grid();
    LAS unsigned char* lds = (LAS unsigned char*)dyn_lds;
    const int G = gridDim.x;
    pg8::StaticOrder S;
    LAS unsigned char* epi_stg = lds + 131072 + (threadIdx.x >> 6) * pg8::EPI_STG_BYTES;
    volatile LAS unsigned* xst = (volatile LAS unsigned*)(lds + LDS_MAIN);
    unsigned* xbar = (unsigned*)(P.ws + WS_BAR);
    if (threadIdx.x == 0) { xst[0] = 0u; xst[1] = 0u; }
    if (blockIdx.x == 0) for (int i = threadIdx.x; i < XCD_BAR_WORDS; i += 512) xbar[i] = 0u;
#ifndef SKIP_P0
    phase0(P, lds);
#endif
#if defined(PROBE_X2) && (PROBE_X2 & 1)
    __syncthreads(); phase0(P, lds);
#endif
    grid.sync();
    const XcdBarrier xb = xcd_barrier_post(xbar, xst);
    { pg8::Gemm gm{(const bf16_t*)P.out, (const bf16_t*)(P.ws + WS_TAIL), TP / 256, NPAD / 256, DM, DM, 0};
      S.init(gm.nM, gm.nN, G, blockIdx.x);
      pg8::EpiInProj E{(bf16_t*)(P.ws + WS_PROJ), epi_stg};
#ifndef SKIP_GEMM
      pg8::gemm_phase(lds, gm, S, E);
#endif
#if defined(PROBE_GEMM2) && (PROBE_GEMM2 & 1)
      __syncthreads();
#ifdef PROBE_SAMETILE
      S.same = true;
#endif
      pg8::gemm_phase<decltype(E), PROBE_NOEPI>(lds, gm, S, E); S.same = false;
#endif
    }
    xcd_barrier(xb);
#ifndef SKIP_P2
    for (int u = blockIdx.x; u < NBATCH * 128 * 8; u += G) ssd_states_unit(P, lds, u);
#endif
#if defined(PROBE_X2) && (PROBE_X2 & 2)
    for (int u = blockIdx.x; u < NBATCH * 128 * 8; u += G) ssd_states_unit(P, lds, u);
#endif
#ifndef SKIP_SC
    for (int t = blockIdx.x * 8 + (threadIdx.x >> 6); t < (MR / 32) * 4; t += G * 8) shortconv_task(P, t, threadIdx.x & 63);
#endif
    xcd_barrier(xb);
#ifndef SKIP_P3
    scan_phase(P);
#endif
#if defined(PROBE_X2) && (PROBE_X2 & 4)
    scan_phase(P);
#endif
    xcd_barrier(xb);
#ifndef SKIP_P4
    for (int u = blockIdx.x; u < NBATCH * 128 * 8; u += G) ssd_out_unit(P, lds, u);
#endif
    xcd_barrier(xb);
    { pg8::Gemm gm{(const bf16_t*)(P.ws + WS_PROJ), (const bf16_t*)(P.ws + WS_WOUT), MR / 256, DM / 256, DMIX, LDP, 1};
      S.init(gm.nM, gm.nN, G, blockIdx.x);
      pg8::EpiBf16<0> E{(bf16_t*)(P.ws + WS_TAIL), DM, epi_stg};
#ifndef SKIP_GEMM
      pg8::gemm_phase<decltype(E), false, PG8_SP2, PG8_ALIGN, true>(lds, gm, S, E);
#endif
#if defined(PROBE_GEMM2) && (PROBE_GEMM2 & 2)
      __syncthreads();
#ifdef PROBE_SAMETILE
      S.same = true;
#endif
      pg8::gemm_phase<decltype(E), PROBE_NOEPI>(lds, gm, S, E); S.same = false;
#endif
    }
    xcd_barrier(xb);
#ifndef SKIP_P6
    post_mix_phase(P);
#endif
    xcd_barrier(xb);
    { pg8::Gemm gm{(const bf16_t*)P.out, (const bf16_t*)(P.ws + WS_W1), MR / 256, DFF / 256, DM, DM, 0};
      S.init(gm.nM, gm.nN, G, blockIdx.x);
      pg8::EpiBf16<1> E{(bf16_t*)(P.ws + WS_HID), DFF, epi_stg};
#ifndef SKIP_GEMM
      pg8::gemm_phase(lds, gm, S, E);
#endif
#if defined(PROBE_GEMM2) && (PROBE_GEMM2 & 4)
      __syncthreads();
#ifdef PROBE_SAMETILE
      S.same = true;
#endif
      pg8::gemm_phase<decltype(E), PROBE_NOEPI>(lds, gm, S, E); S.same = false;
#endif
    }
    xcd_barrier(xb);
    { pg8::Gemm gm{(const bf16_t*)(P.ws + WS_HID), (const bf16_t*)(P.ws + WS_W2), MR / 256, DM / 256, DFF, DFF, 0};
      S.init(gm.nM, gm.nN, G, blockIdx.x);
      pg8::EpiBf16<0> E{(bf16_t*)(P.ws + WS_FF), DM, epi_stg};
#ifndef SKIP_GEMM
      pg8::gemm_phase<decltype(E), false, PG8_SP2, PG8_ALIGN, true>(lds, gm, S, E);
#endif
#if defined(PROBE_GEMM2) && (PROBE_GEMM2 & 8)
      __syncthreads();
#ifdef PROBE_SAMETILE
      S.same = true;
#endif
      pg8::gemm_phase<decltype(E), PROBE_NOEPI>(lds, gm, S, E); S.same = false;
#endif
    }
    xcd_barrier(xb);
#ifndef SKIP_P9
    final_phase(P);
#endif
}

extern "C" void kernel_launch(void* const* d_in, const int* in_sizes, int n_in, void* d_out, int out_size, void* d_ws, size_t ws_size, hipStream_t stream) {
    static int grid = 0;
    if (!grid) {
        if (n_in != 18 || ws_size < WS_END) { fprintf(stderr, "kernel_launch: unexpected n_in %d / ws %zu (need %zu)\n", n_in, ws_size, (size_t)WS_END); grid = -1; return; }
        int dev = 0, cus = 0, per_cu = 0;
        (void)hipGetDevice(&dev);
        (void)hipDeviceGetAttribute(&cus, hipDeviceAttributeMultiprocessorCount, dev);
        (void)hipFuncSetAttribute((const void*)hymba_fwd, hipFuncAttributeMaxDynamicSharedMemorySize, LDS_BYTES);
        (void)hipOccupancyMaxActiveBlocksPerMultiprocessor(&per_cu, (const void*)hymba_fwd, 512, LDS_BYTES);
        if (per_cu < 1) { fprintf(stderr, "kernel_launch: occupancy query says %d blocks per CU\n", per_cu); per_cu = 1; }
        grid = cus;
    }
    if (grid < 0) return;
    Params p{};
    const float** f = (const float**)&p;
    for (int i = 0; i < 18; ++i) f[i] = (const float*)d_in[i];
    p.out = (float*)d_out; p.ws = (unsigned char*)d_ws;
    void* args[] = {&p};
    hipError_t e = hipLaunchCooperativeKernel((const void*)hymba_fwd, dim3(grid), dim3(512), args, LDS_BYTES, stream);
    if (e != hipSuccess) fprintf(stderr, "cooperative launch failed: %s (grid %d)\n", hipGetErrorString(e), grid);
}
```

```cpp
#define EPI_NT 1
#define PG8_SP2 true
#define PG8_ALIGN true
#include <hip/hip_runtime.h>
#include <hip/hip_cooperative_groups.h>
#include <cstdio>
namespace cg = cooperative_groups;

#define LAS __attribute__((address_space(3)))
typedef unsigned short bf16_t;
typedef short bf16x8 __attribute__((ext_vector_type(8)));
typedef float f32x4 __attribute__((ext_vector_type(4)));
typedef float f32x2 __attribute__((ext_vector_type(2)));
typedef unsigned u32x4 __attribute__((ext_vector_type(4)));
typedef unsigned u32x2 __attribute__((ext_vector_type(2)));

constexpr int DM = 2048, NBATCH = 2, SEQ = 16384, NMETA = 16;
constexpr int LP = 16512;
constexpr int TP = NBATCH * LP;
constexpr int MR = NBATCH * SEQ;
constexpr int NIN = 12320, NPAD = 12544;
constexpr int LDP = 10496;
constexpr int COL_GB = 0, COL_Z = 2048, COL_U = 4096, COL_X = 6144, COL_B = 8192, COL_C = 9216, COL_DT = 10240;
constexpr int DFF = 8192, DMIX = 4096;
constexpr float EPS = 1e-6f;
constexpr int LDS_SSD = 147456, LDS_EPI = 131072 + 8 * 2304, LDS_MAIN = LDS_EPI > LDS_SSD ? LDS_EPI : LDS_SSD, LDS_BYTES = LDS_MAIN + 64;

constexpr size_t WS_WOUT = 0;
constexpr size_t WS_W1 = WS_WOUT + (size_t)DM * DMIX * 2;
constexpr size_t WS_W2 = WS_W1 + (size_t)DFF * DM * 2;
constexpr size_t WS_PROJ = WS_W2 + (size_t)DM * DFF * 2;
constexpr size_t WS_PROJ_BYTES = (size_t)MR * DFF * 2 + (size_t)MR * DM * 4;
static_assert(WS_PROJ_BYTES >= (size_t)TP * LDP * 2, "proj");
constexpr size_t WS_TAIL = WS_PROJ + WS_PROJ_BYTES;
constexpr size_t WS_TAIL_BYTES = (size_t)MR * DM * 2;
constexpr size_t WS_DEC = WS_TAIL + WS_TAIL_BYTES;
constexpr size_t WS_BAR = WS_DEC + (size_t)NBATCH * 128 * 32 * 4;
constexpr size_t WS_END = WS_BAR + 3456 * 4;
constexpr size_t WS_HID = WS_PROJ;
constexpr size_t WS_FF = WS_PROJ + (size_t)MR * DFF * 2;

struct Params {
    const float *x, *meta, *w_in, *scw, *cng, *cw, *cb, *dtb, *alog, *dsk, *sng, *w_out, *g_premix, *g_postmix, *g_premlp, *g_postmlp, *w1, *w2;
    float* out; unsigned char* ws;
};

__device__ __forceinline__ unsigned cvt_pk_bf16(float lo, float hi) { unsigned r; asm volatile("v_cvt_pk_bf16_f32 %0, %1, %2" : "=v"(r) : "v"(lo), "v"(hi)); return r; }
__device__ __forceinline__ unsigned pk_bf16_sw(float lo, float hi) { unsigned a = __float_as_uint(lo), b = __float_as_uint(hi); a += 0x7FFFu + ((a >> 16) & 1u); b += 0x7FFFu + ((b >> 16) & 1u); return (a >> 16) | (b & 0xffff0000u); }
__device__ __forceinline__ float bf_lo(unsigned w) { return __uint_as_float(w << 16); }
__device__ __forceinline__ float bf_hi(unsigned w) { return __uint_as_float(w & 0xffff0000u); }
__device__ __forceinline__ float bf2f(bf16_t b) { return __uint_as_float(((unsigned)b) << 16); }
__device__ __forceinline__ float wave_sum(float v) {
#pragma unroll
    for (int o = 1; o < 64; o <<= 1) v += __shfl_xor(v, o);
    return v;
}
__device__ __forceinline__ int opaque_tid() { int t = threadIdx.x; asm volatile("" : "+v"(t)); return t; }
__device__ __forceinline__ float silu_f(float v) { return v * __builtin_amdgcn_rcpf(1.0f + __expf(-v)); }
__device__ __forceinline__ float softplus_f(float v) { return fmaxf(v, 0.f) + log1pf(__expf(-fabsf(v))); }

#ifndef PROBE_NOEPI
#define PROBE_NOEPI false
#endif
namespace pg8 {
#ifdef EPI_NT
#define EPI_STORE(p, v) __builtin_nontemporal_store((v), (p))
#else
#define EPI_STORE(p, v) (*(p) = (v))
#endif
constexpr int BM = 256, BK = 64, HALF = 128, HTB = HALF * BK * 2, STAGE_BYTES = 8 * HTB, NXCD = 8, WGM = 4;
#ifndef PG8_ROWMAJOR
#define PG8_ROWMAJOR 1
#endif
#if PG8_ROWMAJOR
__host__ __device__ __forceinline__ int lds_byte(int r, int c) { return r * 128 + ((((c >> 3) ^ ((r >> 1) & 7)) & 7) << 4) + (c & 7) * 2; }
__host__ __device__ __forceinline__ void stage_rc(int b, int& R, int& C) { R = b / 128; const int ch = (b % 128) / 16; C = ((ch ^ ((R >> 1) & 7)) & 7) * 8; }
#else
__host__ __device__ __forceinline__ int lds_byte(int r, int c) { const int st = (r >> 4) * 2 + (c >> 5), rr = r & 15, cc = c & 31, ob = rr * 64 + cc * 2; return st * 1024 + (ob ^ (((ob >> 9) & 1) << 5)); }
__host__ __device__ __forceinline__ void stage_rc(int b, int& R, int& C) { const int st = b / 1024, sb = b % 1024, swz = sb ^ (((sb >> 9) & 1) << 5); R = (st >> 1) * 16 + swz / 64; C = (st & 1) * 32 + (swz % 64) / 2; }
#endif
__host__ __device__ __forceinline__ int perm32(int rho) { const int n = rho >> 4, i = rho & 15; return 8 * (i >> 2) + 4 * n + (i & 3); }

struct Unit { int pm, pn; };
struct Gemm { const bf16_t* A; const bf16_t* Bt; int nM, nN, K, lda, amode; };

struct StaticOrder {
    int nM, nN, nwg, G, c; bool same = false;
    __device__ void init(int nM_, int nN_, int G_, int c_) { nM = nM_; nN = nN_; nwg = nM * nN; G = G_; c = c_; }
    __device__ bool next(int i, Unit& u) const {
        const long L = (long)i * G + c; if (L >= nwg) return false;
        int wgid = (int)L; { const int q = nwg / NXCD, r = nwg % NXCD, xcd = wgid % NXCD, off = wgid / NXCD; wgid = (xcd < r ? xcd * (q + 1) : r * (q + 1) + (xcd - r) * q) + off; }
        const int nig = WGM * nN, gid = wgid / nig, fm = gid * WGM, gsz = (nM - fm) < WGM ? (nM - fm) : WGM;
        u.pm = fm + ((wgid % nig) % gsz); u.pn = (wgid % nig) / gsz;
#ifdef PROBE_SAMETILE
        if (same) { u.pm = 0; u.pn = 0; }
#endif
        return true;
    }
};

struct EpiF32 {
    static constexpr bool PERM = false;
    float* C; int ldc;
    __device__ __forceinline__ void operator()(const f32x4 (&acc)[2][2][4][2], const Unit& u, int wr, int wc, int fr, int fq) const {
        const int row0 = u.pm * BM + wr * 64 + fr, col0 = u.pn * BM + wc * 32 + 4 * fq;
#pragma unroll
        for (int ai = 0; ai < 2; ++ai)
#pragma unroll
            for (int m = 0; m < 4; ++m) { float* rowp = C + (size_t)(row0 + ai * HALF + m * 16) * ldc + col0;
#pragma unroll
                for (int bj = 0; bj < 2; ++bj)
#pragma unroll
                    for (int n = 0; n < 2; ++n) EPI_STORE((f32x4*)(rowp + bj * HALF + n * 16), acc[ai][bj][m][n]); }
    }
};
constexpr int EPI_STG_PITCH = 144, EPI_STG_BYTES = 16 * EPI_STG_PITCH;
__device__ __forceinline__ void epi_store_rows(LAS unsigned char* stg, bf16_t* gbase, size_t ldc, const u32x4& w0, const u32x4& w1, int fr, int fq) {
    *(LAS u32x4*)(stg + fr * EPI_STG_PITCH + fq * 16) = w0;
    *(LAS u32x4*)(stg + fr * EPI_STG_PITCH + (4 + fq) * 16) = w1;
    const int lane = fr + 16 * fq, rr = lane >> 3, cc = lane & 7;
    const u32x4 a = *(const LAS u32x4*)(stg + rr * EPI_STG_PITCH + cc * 16);
    const u32x4 b = *(const LAS u32x4*)(stg + (8 + rr) * EPI_STG_PITCH + cc * 16);
    EPI_STORE((u32x4*)(gbase + (size_t)rr * ldc + cc * 8), a);
    EPI_STORE((u32x4*)(gbase + (size_t)(8 + rr) * ldc + cc * 8), b);
}
template <int ACT  > struct EpiBf16 {
    static constexpr bool PERM = true;
    bf16_t* O; int ldc; LAS unsigned char* stg;
    __device__ __forceinline__ void operator()(const f32x4 (&acc)[2][2][4][2], const Unit& u, int wr, int wc, int fr, int fq) const {
        bf16_t* tile = O + (size_t)(u.pm * BM + wr * 64) * ldc + u.pn * BM + wc * 64;
#pragma unroll
        for (int ai = 0; ai < 2; ++ai)
#pragma unroll
            for (int m = 0; m < 4; ++m) {
                u32x4 w[2];
#pragma unroll
                for (int bj = 0; bj < 2; ++bj) { f32x4 v0 = acc[ai][bj][m][0], v1 = acc[ai][bj][m][1];
                    if (ACT == 1) {
#pragma unroll
                        for (int j = 0; j < 4; ++j) { const float a = fmaxf(v0[j], 0.f), b = fmaxf(v1[j], 0.f); v0[j] = a * a; v1[j] = b * b; } }
                    w[bj].x = cvt_pk_bf16(v0[0], v0[1]); w[bj].y = cvt_pk_bf16(v0[2], v0[3]); w[bj].z = cvt_pk_bf16(v1[0], v1[1]); w[bj].w = cvt_pk_bf16(v1[2], v1[3]); }
                epi_store_rows(stg, tile + (size_t)(ai * HALF + m * 16) * ldc, ldc, w[0], w[1], fr, fq); }
    }
};

struct EpiInProj {
    static constexpr bool PERM = true;
    bf16_t* O; LAS unsigned char* stg;
    __device__ __forceinline__ void operator()(const f32x4 (&acc)[2][2][4][2], const Unit& u, int wr, int wc, int fr, int fq) const {
        const int row0 = u.pm * BM + wr * 64 + fr;
        if (u.pn >= 16 && u.pn < 32) {
            const int col0 = COL_U + 128 * (u.pn - 16) + wc * 32 + 8 * fq;
#pragma unroll
            for (int ai = 0; ai < 2; ++ai)
#pragma unroll
                for (int m = 0; m < 4; ++m) { bf16_t* rowp = O + (size_t)(row0 + ai * HALF + m * 16) * LDP + col0;
                    const f32x4 v0 = acc[ai][0][m][0] * acc[ai][1][m][0], v1 = acc[ai][0][m][1] * acc[ai][1][m][1];
                    u32x4 w; w.x = cvt_pk_bf16(v0[0], v0[1]); w.y = cvt_pk_bf16(v0[2], v0[3]); w.z = cvt_pk_bf16(v1[0], v1[1]); w.w = cvt_pk_bf16(v1[2], v1[3]);
                    EPI_STORE((u32x4*)rowp, w); }
        } else {
            bf16_t* tile = O + (size_t)(u.pm * BM + wr * 64) * LDP + (u.pn < 16 ? 256 * u.pn : COL_X + 256 * (u.pn - 32)) + wc * 64;
#pragma unroll
            for (int ai = 0; ai < 2; ++ai)
#pragma unroll
                for (int m = 0; m < 4; ++m) {
                    u32x4 w[2];
#pragma unroll
                    for (int bj = 0; bj < 2; ++bj) { const f32x4 v0 = acc[ai][bj][m][0], v1 = acc[ai][bj][m][1];
                        w[bj].x = cvt_pk_bf16(v0[0], v0[1]); w[bj].y = cvt_pk_bf16(v0[2], v0[3]); w[bj].z = cvt_pk_bf16(v1[0], v1[1]); w[bj].w = cvt_pk_bf16(v1[2], v1[3]); }
                    epi_store_rows(stg, tile + (size_t)(ai * HALF + m * 16) * LDP, LDP, w[0], w[1], fr, fq); }
        }
    }
};
#ifndef PG8_SP2
#define PG8_SP2 false
#endif
#ifndef PG8_ALIGN
#define PG8_ALIGN false
#endif
template <class Epi, bool NOEPI = false, bool SP2 = PG8_SP2, bool ALIGN_EPI = PG8_ALIGN>
__device__ __forceinline__ void gemm_phase(LAS unsigned char* lds, const Gemm g, const StaticOrder& S, const Epi& E) {
    const int tid = opaque_tid(), wid = __builtin_amdgcn_readfirstlane(tid >> 6), lane = tid & 63, wr = wid >> 2, wc = wid & 3, fr = lane & 15, fq = lane >> 4;
    const int K = g.K, nt = K / BK, lda = g.lda;
    unsigned voffA[2], voffB[2], voffB1[2];
#pragma unroll
    for (int i = 0; i < 2; ++i) { int R, C; stage_rc(tid * 16 + i * 8192, R, C); const int Rb = Epi::PERM ? ((R & ~31) + perm32(R & 31)) : R;
        const int Rb0 = Epi::PERM ? (64 * (R >> 5) + perm32(R & 31)) : R, Rb1 = Epi::PERM ? (64 * (R >> 5) + 32 + perm32(R & 31)) : (HALF + R); (void)Rb;
        voffA[i] = (unsigned)(R * lda + C) * 2u; voffB[i] = (unsigned)(Rb0 * K + C) * 2u; voffB1[i] = (unsigned)(Rb1 * K + C) * 2u; }
    const size_t kstep = (size_t)(BK * 2);
    const size_t hstepA = (size_t)HALF * lda * 2, hstepB = (size_t)HALF * K * 2;
    const unsigned ldsw = (unsigned)wid * 1024u;
    const int aoff[2] = {lds_byte(wr * 64 + fr, fq * 8), lds_byte(wr * 64 + fr, 32 + fq * 8)}, boff[2] = {lds_byte(wc * 32 + fr, fq * 8), lds_byte(wc * 32 + fr, 32 + fq * 8)};
#define PG8_SA(b, h) (((b) * 2 + (h)) * HTB)
#define PG8_SB(b, h) ((4 + (b) * 2 + (h)) * HTB)
#define PG8_STAGE(bufoff, gbase, voff) do { _Pragma("unroll") for (int _i = 0; _i < 2; ++_i) \
        __builtin_amdgcn_global_load_lds((const unsigned*)((const char*)(gbase) + (voff)[_i]), (LAS unsigned*)(lds + (bufoff) + ldsw + _i * 8192), 16, 0, 0); } while (0)
#define PG8_LDA(dst, b, h) do { _Pragma("unroll") for (int m = 0; m < 4; ++m) _Pragma("unroll") for (int k = 0; k < 2; ++k) dst[m][k] = *(const LAS bf16x8*)(lds + PG8_SA(b, h) + aoff[k] + m * 2048); } while (0)
#define PG8_LDB(dst, b, h) do { _Pragma("unroll") for (int n = 0; n < 2; ++n) _Pragma("unroll") for (int k = 0; k < 2; ++k) dst[n][k] = *(const LAS bf16x8*)(lds + PG8_SB(b, h) + boff[k] + n * 2048); } while (0)
#define PG8_MMA(ai, bj, At, Bt) do { __builtin_amdgcn_s_setprio(1); _Pragma("unroll") for (int m = 0; m < 4; ++m) _Pragma("unroll") for (int n = 0; n < 2; ++n) _Pragma("unroll") for (int k = 0; k < 2; ++k) \
        acc[ai][bj][m][n] = __builtin_amdgcn_mfma_f32_16x16x32_bf16(Bt[n][k], At[m][k], acc[ai][bj][m][n], 0, 0, 0); __builtin_amdgcn_s_setprio(0); } while (0)
#define PG8_WAIT_V(n) asm volatile("s_waitcnt vmcnt(" #n ")" ::: "memory")
#define PG8_WAIT_L(n) asm volatile("s_waitcnt lgkmcnt(" #n ")" ::: "memory")
#define PG8_BAR __builtin_amdgcn_s_barrier()
#define PG8_SCHED __builtin_amdgcn_sched_barrier(0)
#define PG8_AROW(pm) ((size_t)((pm) * BM + (g.amode ? 128 + 128 * ((pm) >> 6) : 0)))
    Unit cur, nxt; int ui = 0;
    if (!S.next(0, cur)) return;
#ifdef STAGGER_TICKS
#ifndef STAGGER_XCD
#define STAGGER_XCD 0
#endif
    { const unsigned long long t0 = __builtin_amdgcn_s_memrealtime(), dl = (unsigned long long)(STAGGER_XCD ? (S.c & 7) : (S.c >> 3)) * STAGGER_TICKS;
      while (__builtin_amdgcn_s_memrealtime() - t0 < dl) __builtin_amdgcn_s_sleep(8); }
#endif
    f32x4 acc[2][2][4][2];
#pragma unroll
    for (int a = 0; a < 2; ++a)
#pragma unroll
        for (int b = 0; b < 2; ++b)
#pragma unroll
            for (int m = 0; m < 4; ++m)
#pragma unroll
                for (int n = 0; n < 2; ++n) acc[a][b][m][n] = (f32x4){0.f, 0.f, 0.f, 0.f};
    bf16x8 At[4][2], B0[2][2], B1[2][2];
    const char* cA = (const char*)g.A + PG8_AROW(cur.pm) * lda * 2; const char* cB = (const char*)g.Bt + (size_t)cur.pn * BM * K * 2;
    if constexpr (SP2) {
        PG8_STAGE(PG8_SB(0, 0), cB, voffB); PG8_STAGE(PG8_SB(0, 1), cB, voffB1); PG8_STAGE(PG8_SA(0, 0), cA, voffA); PG8_STAGE(PG8_SA(0, 1), cA + hstepA, voffA);
        if (wr == 1) PG8_BAR;
        PG8_WAIT_V(2); PG8_BAR;
        PG8_STAGE(PG8_SB(1, 0), cB + kstep, voffB); PG8_STAGE(PG8_SA(1, 0), cA + kstep, voffA); PG8_STAGE(PG8_SB(1, 1), cB + kstep, voffB1);
        PG8_WAIT_V(6); PG8_BAR;
    } else {
    PG8_STAGE(PG8_SB(0, 0), cB, voffB); PG8_STAGE(PG8_SA(0, 0), cA, voffA); PG8_STAGE(PG8_SB(0, 1), cB, voffB1); PG8_STAGE(PG8_SA(0, 1), cA + hstepA, voffA);
    if (wr == 1) PG8_BAR;
    PG8_WAIT_V(4); PG8_BAR;
    PG8_STAGE(PG8_SB(1, 0), cB + kstep, voffB); PG8_STAGE(PG8_SA(1, 0), cA + kstep, voffA); PG8_STAGE(PG8_SB(1, 1), cB + kstep, voffB1);
    PG8_WAIT_V(6); PG8_BAR;
    }
    for (;;) {
        const bool has_next = S.next(ui + 1, nxt);
        const char* nA = has_next ? (const char*)g.A + PG8_AROW(nxt.pm) * lda * 2 : cA; const char* nB = has_next ? (const char*)g.Bt + (size_t)nxt.pn * BM * K * 2 : cB;
        for (int t = 0; t < nt; t += 2) {
            const bool last = (t == nt - 2);
            const char* a1 = cA + (size_t)(t + 1) * kstep;
            const char* a2 = last ? nA : cA + (size_t)(t + 2) * kstep; const char* b2 = last ? nB : cB + (size_t)(t + 2) * kstep;
            const char* a3 = a2 + kstep; const char* b3 = b2 + kstep;
            if constexpr (SP2) {
            PG8_LDB(B0, 0, 0); PG8_LDB(B1, 0, 1); PG8_SCHED; PG8_LDA(At, 0, 0); PG8_STAGE(PG8_SA(1, 1), a1 + hstepA, voffA);
            PG8_WAIT_V(8); PG8_WAIT_L(0); PG8_BAR; PG8_MMA(0, 0, At, B0); PG8_MMA(0, 1, At, B1); PG8_BAR; PG8_SCHED;
            PG8_LDA(At, 0, 1); PG8_STAGE(PG8_SB(0, 0), b2, voffB); PG8_STAGE(PG8_SB(0, 1), b2, voffB1); PG8_STAGE(PG8_SA(0, 0), a2, voffA);
            PG8_WAIT_V(8); PG8_WAIT_L(0); PG8_BAR; PG8_MMA(1, 0, At, B0); PG8_MMA(1, 1, At, B1); PG8_BAR; PG8_SCHED;
            PG8_LDB(B0, 1, 0); PG8_LDB(B1, 1, 1); PG8_SCHED; PG8_LDA(At, 1, 0); PG8_STAGE(PG8_SA(0, 1), a2 + hstepA, voffA);
            PG8_WAIT_V(8); PG8_WAIT_L(0); PG8_BAR; PG8_MMA(0, 0, At, B0); PG8_MMA(0, 1, At, B1); PG8_BAR; PG8_SCHED;
            PG8_LDA(At, 1, 1); PG8_STAGE(PG8_SB(1, 0), b3, voffB); PG8_STAGE(PG8_SB(1, 1), b3, voffB1); PG8_STAGE(PG8_SA(1, 0), a3, voffA);
            PG8_WAIT_V(8); PG8_WAIT_L(0); PG8_BAR; PG8_MMA(1, 0, At, B0); PG8_MMA(1, 1, At, B1); PG8_BAR; PG8_SCHED;
            } else {
            PG8_LDB(B0, 0, 0); PG8_SCHED; PG8_LDA(At, 0, 0); PG8_STAGE(PG8_SA(1, 1), a1 + hstepA, voffA);
            PG8_WAIT_L(8); PG8_BAR; PG8_WAIT_L(0); PG8_MMA(0, 0, At, B0); PG8_BAR; PG8_SCHED;
            PG8_LDB(B1, 0, 1); PG8_STAGE(PG8_SB(0, 0), b2, voffB);
            PG8_BAR; PG8_WAIT_L(0); PG8_MMA(0, 1, At, B1); PG8_BAR;
            PG8_LDA(At, 0, 1); PG8_STAGE(PG8_SA(0, 0), a2, voffA);
            PG8_BAR; PG8_WAIT_L(0); PG8_MMA(1, 0, At, B0); PG8_BAR; PG8_SCHED;
            PG8_STAGE(PG8_SB(0, 1), b2, voffB1);
            PG8_WAIT_V(6); PG8_BAR; PG8_MMA(1, 1, At, B1); PG8_BAR;
            PG8_LDB(B0, 1, 0); PG8_SCHED; PG8_LDA(At, 1, 0); PG8_STAGE(PG8_SA(0, 1), a2 + hstepA, voffA);
            PG8_WAIT_L(8); PG8_BAR; PG8_WAIT_L(0); PG8_MMA(0, 0, At, B0); PG8_BAR; PG8_SCHED;
            PG8_LDB(B1, 1, 1); PG8_STAGE(PG8_SB(1, 0), b3, voffB);
            PG8_BAR; PG8_WAIT_L(0); PG8_MMA(0, 1, At, B1); PG8_BAR;
            PG8_LDA(At, 1, 1); PG8_STAGE(PG8_SA(1, 0), a3, voffA);
            PG8_BAR; PG8_WAIT_L(0); PG8_MMA(1, 0, At, B0); PG8_BAR; PG8_SCHED;
            PG8_STAGE(PG8_SB(1, 1), b3, voffB1);
            PG8_WAIT_V(6); PG8_BAR; PG8_MMA(1, 1, At, B1); PG8_BAR;
            }
        }
        if constexpr (ALIGN_EPI) { if (wr == 0) PG8_BAR; }
        if (!NOEPI) E(acc, cur, wr, wc, fr, fq);
        else { float sink = 0.f; _Pragma("unroll") for (int a = 0; a < 2; ++a) _Pragma("unroll") for (int b = 0; b < 2; ++b) _Pragma("unroll") for (int m = 0; m < 4; ++m) _Pragma("unroll") for (int n = 0; n < 2; ++n) sink += acc[a][b][m][n][0] + acc[a][b][m][n][1] + acc[a][b][m][n][2] + acc[a][b][m][n][3]; if (sink == 12345.678f) *(float*)g.A = sink; }
        if (!has_next) break;
#pragma unroll
        for (int a = 0; a < 2; ++a)
#pragma unroll
            for (int b = 0; b < 2; ++b)
#pragma unroll
                for (int m = 0; m < 4; ++m)
#pragma unroll
                    for (int n = 0; n < 2; ++n) acc[a][b][m][n] = (f32x4){0.f, 0.f, 0.f, 0.f};
        cur = nxt; cA = nA; cB = nB; ++ui;
        if constexpr (ALIGN_EPI) { if (wr == 1) PG8_BAR; }
    }
    PG8_WAIT_V(0);
    if constexpr (!ALIGN_EPI) { if (wr == 0) PG8_BAR; }
    PG8_BAR;
#undef PG8_SA
#undef PG8_SB
#undef PG8_STAGE
#undef PG8_LDA
#undef PG8_LDB
#undef PG8_MMA
#undef PG8_WAIT_V
#undef PG8_WAIT_L
#undef PG8_BAR
#undef PG8_SCHED
#undef PG8_AROW
}
}

__device__ __forceinline__ void p0_transpose_item(const float* W, int K, int N, bf16_t* WT, int drow0, int scol0, int k0, LAS float* scr, int lane) {
    if (scol0 >= 0) {
#pragma unroll 8
        for (int i = 0; i < 32; ++i) { const int kk = 2 * i + (lane >> 5); scr[kk * 33 + (lane & 31)] = W[(size_t)(k0 + kk) * N + scol0 + (lane & 31)]; }
    } else {
#pragma unroll 8
        for (int i = 0; i < 32; ++i) { const int kk = 2 * i + (lane >> 5); scr[kk * 33 + (lane & 31)] = 0.f; }
    }
    asm volatile("s_waitcnt lgkmcnt(0)" ::: "memory");
    const int c = lane & 7;
#pragma unroll
    for (int j = 0; j < 4; ++j) { const int n = (lane >> 3) + 8 * j; const LAS float* s = scr + (8 * c) * 33 + n;
        u32x4 o; o.x = cvt_pk_bf16(s[0 * 33], s[1 * 33]); o.y = cvt_pk_bf16(s[2 * 33], s[3 * 33]); o.z = cvt_pk_bf16(s[4 * 33], s[5 * 33]); o.w = cvt_pk_bf16(s[6 * 33], s[7 * 33]);
        *(u32x4*)(WT + (size_t)(drow0 + n) * K + k0 + 8 * c) = o; }
    asm volatile("s_waitcnt lgkmcnt(0)" ::: "memory");
}
__device__ __forceinline__ int win_src_col(int n) {
    if (n < 2048) return n;
    if (n < 4096) return 6144 + (n - 2048);
    if (n < 8192) { const int m = n - 4096, t = m >> 8, j = m & 255, wc = j >> 6, bj = (j >> 5) & 1; return (bj ? 4096 : 2048) + 128 * t + 32 * wc; }
    if (n < NIN) return n;
    return -1;
}
__device__ __forceinline__ void phase0(const Params& P, LAS unsigned char* lds) {
    const int tid = opaque_tid(), lane = tid & 63, wave = tid >> 6;
    LAS float* scr = (LAS float*)(lds + wave * 16384);
    const int gw = blockIdx.x * 8 + wave, NGW = gridDim.x * 8;
    bf16_t* WinT = (bf16_t*)(P.ws + WS_TAIL); bf16_t* WoutT = (bf16_t*)(P.ws + WS_WOUT); bf16_t* W1T = (bf16_t*)(P.ws + WS_W1); bf16_t* W2T = (bf16_t*)(P.ws + WS_W2);
    constexpr int I_IN = (DM / 64) * (NPAD / 32), I_OUT = (DMIX / 64) * (DM / 32), I_1 = (DM / 64) * (DFF / 32), I_2 = (DFF / 64) * (DM / 32);
    for (int it = gw; it < I_IN + I_OUT + I_1 + I_2; it += NGW) {
        int r = it;
        if (r < I_IN) { const int nb = r % (NPAD / 32), kb = r / (NPAD / 32); p0_transpose_item(P.w_in, DM, NIN, WinT, nb * 32, win_src_col(nb * 32), kb * 64, scr, lane); continue; } r -= I_IN;
        if (r < I_OUT) { const int nb = r % (DM / 32), kb = r / (DM / 32); p0_transpose_item(P.w_out, DMIX, DM, WoutT, nb * 32, nb * 32, kb * 64, scr, lane); continue; } r -= I_OUT;
        if (r < I_1) { const int nb = r % (DFF / 32), kb = r / (DFF / 32); p0_transpose_item(P.w1, DM, DFF, W1T, nb * 32, nb * 32, kb * 64, scr, lane); continue; } r -= I_1;
        { const int nb = r % (DM / 32), kb = r / (DM / 32); p0_transpose_item(P.w2, DFF, DM, W2T, nb * 32, nb * 32, kb * 64, scr, lane); }
    }
    bf16_t* HN = (bf16_t*)P.out;
    for (int r = gw; r < TP; r += NGW) {
        const int b = r / LP, p = r % LP;
        u32x2* o8 = (u32x2*)(HN + (size_t)r * DM) + lane;
        if (p < 112) {
#pragma unroll
            for (int j = 0; j < 8; ++j) o8[64 * j] = (u32x2){0u, 0u};
            continue;
        }
        const float* src = (p < 128) ? P.meta + (size_t)(p - 112) * DM : P.x + ((size_t)b * SEQ + (p - 128)) * DM;
        const f32x4* xr = (const f32x4*)src + lane; const f32x4* gr = (const f32x4*)P.g_premix + lane;
        f32x4 v[8]; float s = 0.f;
#pragma unroll
        for (int j = 0; j < 8; ++j) { v[j] = __builtin_nontemporal_load(xr + 64 * j); s += (v[j].x * v[j].x + v[j].y * v[j].y) + (v[j].z * v[j].z + v[j].w * v[j].w); }
        const float rs = rsqrtf(wave_sum(s) * (1.f / DM) + EPS);
#pragma unroll
        for (int j = 0; j < 8; ++j) { const f32x4 gg = gr[64 * j]; o8[64 * j] = (u32x2){cvt_pk_bf16(v[j].x * rs * gg.x, v[j].y * rs * gg.y), cvt_pk_bf16(v[j].z * rs * gg.z, v[j].w * rs * gg.w)}; }
    }
}

constexpr int LROW = 272;
constexpr int L_CS = 0, L_DT = 2048, L_WG = 4096, L_TOT = 6144, L_X = 8192, L_B = L_X + 256 * LROW, L_P0 = L_B + 128 * LROW, L_P1 = L_P0 + 64 * LROW;
static_assert(L_P1 + 64 * LROW <= LDS_SSD, "lds");

__device__ __forceinline__ bf16_t ssd_dt_load(const bf16_t* proj, size_t R0, int g) {
    const int tid = opaque_tid(), hh = tid >> 7, l = tid & 127, head = 4 * g + hh;
    return proj[(R0 + l) * LDP + COL_DT + head];
}
__device__ __forceinline__ void ssd_dt_prologue(const Params& P, LAS unsigned char* lds, bf16_t rawb, int g) {
    const int tid = opaque_tid(), lane = tid & 63, wid = tid >> 6, hh = tid >> 7, l = tid & 127, head = 4 * g + hh;
    LAS float* cs = (LAS float*)(lds + L_CS); LAS float* dt = (LAS float*)(lds + L_DT); LAS float* tot = (LAS float*)(lds + L_TOT);
    const float raw = bf2f(rawb);
    const float dtv = softplus_f(raw + P.dtb[head]);
    float s = -__expf(P.alog[head]) * dtv;
#pragma unroll
    for (int o = 1; o < 64; o <<= 1) { const float t = __shfl_up(s, o); if (lane >= o) s += t; }
    if (lane == 63) tot[wid] = s;
    __syncthreads();
    if (wid & 1) s += tot[wid - 1];
    cs[hh * 128 + l] = s; dt[hh * 128 + l] = dtv;
    __syncthreads();
}

struct XRows { unsigned w[35]; };
__device__ __forceinline__ void ssd_conv_x_load(XRows& xr, const bf16_t* proj, size_t R0, int c, int g) {
    const int tid = opaque_tid(), cp = tid & 127, run = tid >> 7;
    const bf16_t* src = proj + COL_X + 256 * g + 2 * cp;
    const int l0 = 32 * run;
#pragma unroll
    for (int k = 0; k < 35; ++k) { const int li = l0 - 3 + k; xr.w[k] = (c > 0 || li >= 0) ? *(const unsigned*)(src + (size_t)((long)R0 + li) * LDP) : 0u; }
}
template <bool SCALE>
__device__ __forceinline__ void ssd_conv_x(const Params& P, LAS unsigned char* lds, const XRows& xr, int g) {
    const int tid = opaque_tid(), cp = tid & 127, run = tid >> 7, ch = 2 * cp, hh = cp >> 5;
    const int xc = 256 * g + ch;
    float w0[4], w1[4];
#pragma unroll
    for (int k = 0; k < 4; ++k) { w0[k] = P.cw[k * 4096 + xc]; w1[k] = P.cw[k * 4096 + xc + 1]; }
    const float b0 = P.cb[xc], b1 = P.cb[xc + 1];
    const LAS float* wg = (const LAS float*)(lds + L_WG) + hh * 128;
    const int l0 = 32 * run;
#pragma unroll
    for (int i = 0; i < 32; i += 8) {
        float o0[8], o1[8];
#pragma unroll
        for (int j = 0; j < 8; ++j) {
            const int t = i + j;
            float y0 = b0 + w0[0] * bf_lo(xr.w[t]) + w0[1] * bf_lo(xr.w[t + 1]) + w0[2] * bf_lo(xr.w[t + 2]) + w0[3] * bf_lo(xr.w[t + 3]);
            float y1 = b1 + w1[0] * bf_hi(xr.w[t]) + w1[1] * bf_hi(xr.w[t + 1]) + w1[2] * bf_hi(xr.w[t + 2]) + w1[3] * bf_hi(xr.w[t + 3]);
            y0 = silu_f(y0); y1 = silu_f(y1);
            if (SCALE) { const float sc = wg[l0 + t]; y0 *= sc; y1 *= sc; }
            o0[j] = y0; o1[j] = y1;
        }
        u32x4 q0, q1;
        q0.x = cvt_pk_bf16(o0[0], o0[1]); q0.y = cvt_pk_bf16(o0[2], o0[3]); q0.z = cvt_pk_bf16(o0[4], o0[5]); q0.w = cvt_pk_bf16(o0[6], o0[7]);
        q1.x = cvt_pk_bf16(o1[0], o1[1]); q1.y = cvt_pk_bf16(o1[2], o1[3]); q1.z = cvt_pk_bf16(o1[4], o1[5]); q1.w = cvt_pk_bf16(o1[6], o1[7]);
        *(LAS u32x4*)(lds + L_X + ch * LROW + (l0 + i) * 2) = q0;
        *(LAS u32x4*)(lds + L_X + (ch + 1) * LROW + (l0 + i) * 2) = q1;
    }
}

__device__ __forceinline__ void ssd_states_unit(const Params& P, LAS unsigned char* lds, int unit) {
    const int g = unit & 7, c = (unit >> 3) & 127, b = unit >> 10;
    const int tid = opaque_tid(), lane = tid & 63, wid = tid >> 6, fr = lane & 15, fq = lane >> 4;
    const bf16_t* proj = (const bf16_t*)(P.ws + WS_PROJ);
    const size_t R0 = (size_t)b * LP + (size_t)c * 128;
    const bf16_t rawdt = ssd_dt_load(proj, R0, g);
    XRows xr; ssd_conv_x_load(xr, proj, R0, c, g);
    unsigned bwv[19];
    {
        const int cp = tid & 63, run = tid >> 6, l0 = 16 * run;
        const bf16_t* src = proj + COL_B + 128 * g + 2 * cp;
#pragma unroll
        for (int k = 0; k < 19; ++k) { const int li = l0 - 3 + k; bwv[k] = (c > 0 || li >= 0) ? *(const unsigned*)(src + (size_t)((long)R0 + li) * LDP) : 0u; }
    }
    ssd_dt_prologue(P, lds, rawdt, g);
    {
        const int hh = tid >> 7, l = tid & 127;
        const LAS float* cs = (const LAS float*)(lds + L_CS) + hh * 128; const LAS float* dt = (const LAS float*)(lds + L_DT) + hh * 128;
        const float ce = cs[127];
        float w = dt[l] * __expf(ce - cs[l]);
        if (c == 0 && l < 112) w = 0.f;
        ((LAS float*)(lds + L_WG))[hh * 128 + l] = w;
        if (l == 127) ((float*)(P.ws + WS_DEC))[(b * 128 + c) * 32 + 4 * g + hh] = __expf(ce);
    }
    __syncthreads();
    ssd_conv_x<true>(P, lds, xr, g);
    {
        const int cp = tid & 63, run = tid >> 6, n0 = 2 * cp, bc = 2048 + 128 * g + n0;
        float w0[4], w1[4];
#pragma unroll
        for (int k = 0; k < 4; ++k) { w0[k] = P.cw[k * 4096 + bc]; w1[k] = P.cw[k * 4096 + bc + 1]; }
        const float b0 = P.cb[bc], b1 = P.cb[bc + 1];
        const int l0 = 16 * run;
#pragma unroll
        for (int i = 0; i < 16; i += 8) {
            float o0[8], o1[8];
#pragma unroll
            for (int j = 0; j < 8; ++j) {
                const int t = i + j;
                o0[j] = silu_f(b0 + w0[0] * bf_lo(bwv[t]) + w0[1] * bf_lo(bwv[t + 1]) + w0[2] * bf_lo(bwv[t + 2]) + w0[3] * bf_lo(bwv[t + 3]));
                o1[j] = silu_f(b1 + w1[0] * bf_hi(bwv[t]) + w1[1] * bf_hi(bwv[t + 1]) + w1[2] * bf_hi(bwv[t + 2]) + w1[3] * bf_hi(bwv[t + 3]));
            }
            u32x4 q0, q1;
            q0.x = cvt_pk_bf16(o0[0], o0[1]); q0.y = cvt_pk_bf16(o0[2], o0[3]); q0.z = cvt_pk_bf16(o0[4], o0[5]); q0.w = cvt_pk_bf16(o0[6], o0[7]);
            q1.x = cvt_pk_bf16(o1[0], o1[1]); q1.y = cvt_pk_bf16(o1[2], o1[3]); q1.z = cvt_pk_bf16(o1[4], o1[5]); q1.w = cvt_pk_bf16(o1[6], o1[7]);
            *(LAS u32x4*)(lds + L_B + n0 * LROW + (l0 + i) * 2) = q0;
            *(LAS u32x4*)(lds + L_B + (n0 + 1) * LROW + (l0 + i) * 2) = q1;
        }
    }
    __syncthreads();
    f32x4 acc[2][8];
#pragma unroll
    for (int i = 0; i < 2; ++i)
#pragma unroll
        for (int nt = 0; nt < 8; ++nt) acc[i][nt] = (f32x4){0.f, 0.f, 0.f, 0.f};
#pragma unroll
    for (int ks = 0; ks < 4; ++ks) {
        bf16x8 xf[2];
#pragma unroll
        for (int i = 0; i < 2; ++i) xf[i] = *(const LAS bf16x8*)(lds + L_X + (16 * (2 * wid + i) + fr) * LROW + (32 * ks + 8 * fq) * 2);
#pragma unroll
        for (int nt = 0; nt < 8; ++nt) {
            const bf16x8 bfr = *(const LAS bf16x8*)(lds + L_B + (16 * nt + fr) * LROW + (32 * ks + 8 * fq) * 2);
#pragma unroll
            for (int i = 0; i < 2; ++i) acc[i][nt] = __builtin_amdgcn_mfma_f32_16x16x32_bf16(bfr, xf[i], acc[i][nt], 0, 0, 0);
        }
    }
    __syncthreads();
    {
        LAS unsigned char* stg = lds + L_X + wid * (32 * LROW);
#pragma unroll
        for (int i = 0; i < 2; ++i)
#pragma unroll
            for (int nt = 0; nt < 8; ++nt) { const f32x4 a = acc[i][nt]; *(LAS u32x2*)(stg + (16 * i + fr) * LROW + (16 * nt + 4 * fq) * 2) = (u32x2){pk_bf16_sw(a.x, a.y), pk_bf16_sw(a.z, a.w)}; }
        bf16_t* Sg = (bf16_t*)(P.ws + WS_TAIL) + ((size_t)(b * 128 + c) * 32 + 4 * g + (wid >> 1)) * 8192 + (size_t)((32 * wid) & 63) * 128;
        const int rsub = lane >> 4, ck = lane & 15;
#pragma unroll
        for (int j = 0; j < 8; ++j) { const u32x4 v = *(const LAS u32x4*)(stg + (4 * j + rsub) * LROW + ck * 16); *(u32x4*)(Sg + (4 * j + rsub) * 128 + ck * 8) = v; }
    }
}

__device__ __forceinline__ void shortconv_task(const Params& P, int task, int lane) {
    bf16_t* proj = (bf16_t*)(P.ws + WS_PROJ);
    const int q = task & 3, run = task >> 2, m0 = run * 32;
    const size_t row0 = (size_t)m0 + 128 + 128 * (m0 >> 14);
    const int ch0 = 512 * q + 8 * lane;
    float w[3][8], gn[8];
#pragma unroll
    for (int k = 0; k < 3; ++k) { const f32x4 a = *(const f32x4*)(P.scw + k * 2048 + ch0), bq = *(const f32x4*)(P.scw + k * 2048 + ch0 + 4);
        w[k][0] = a.x; w[k][1] = a.y; w[k][2] = a.z; w[k][3] = a.w; w[k][4] = bq.x; w[k][5] = bq.y; w[k][6] = bq.z; w[k][7] = bq.w; }
    { const f32x4 a = *(const f32x4*)(P.cng + ch0), bq = *(const f32x4*)(P.cng + ch0 + 4); gn[0] = a.x; gn[1] = a.y; gn[2] = a.z; gn[3] = a.w; gn[4] = bq.x; gn[5] = bq.y; gn[6] = bq.z; gn[7] = bq.w; }
    float u1[8], u2[8];
#pragma unroll
    for (int k = 0; k < 2; ++k) {
        const size_t r = row0 - 2 + k;
        const u32x4 uu = *(const u32x4*)(proj + r * LDP + COL_U + ch0);
        float* dst = (k == 0) ? u2 : u1;
        dst[0] = bf_lo(uu.x); dst[1] = bf_hi(uu.x); dst[2] = bf_lo(uu.y); dst[3] = bf_hi(uu.y); dst[4] = bf_lo(uu.z); dst[5] = bf_hi(uu.z); dst[6] = bf_lo(uu.w); dst[7] = bf_hi(uu.w);
    }
#pragma unroll 4
    for (int t = 0; t < 32; ++t) {
        const size_t r = row0 + t;
        const u32x4 uu = *(const u32x4*)(proj + r * LDP + COL_U + ch0), gb = *(const u32x4*)(proj + r * LDP + COL_GB + ch0);
        float u0[8], gbf[8], y[8];
        u0[0] = bf_lo(uu.x); u0[1] = bf_hi(uu.x); u0[2] = bf_lo(uu.y); u0[3] = bf_hi(uu.y); u0[4] = bf_lo(uu.z); u0[5] = bf_hi(uu.z); u0[6] = bf_lo(uu.w); u0[7] = bf_hi(uu.w);
        gbf[0] = bf_lo(gb.x); gbf[1] = bf_hi(gb.x); gbf[2] = bf_lo(gb.y); gbf[3] = bf_hi(gb.y); gbf[4] = bf_lo(gb.z); gbf[5] = bf_hi(gb.z); gbf[6] = bf_lo(gb.w); gbf[7] = bf_hi(gb.w);
        float ss = 0.f;
#pragma unroll
        for (int j = 0; j < 8; ++j) { y[j] = gbf[j] * (w[2][j] * u0[j] + w[1][j] * u1[j] + w[0][j] * u2[j]); ss += y[j] * y[j]; u2[j] = u1[j]; u1[j] = u0[j]; }
        ss += __shfl_xor(ss, 1); ss += __shfl_xor(ss, 2); ss += __shfl_xor(ss, 4); ss += __shfl_xor(ss, 8);
        const float rs = rsqrtf(ss * (1.f / 128.f) + EPS);
        u32x4 o; o.x = cvt_pk_bf16(y[0] * rs * gn[0], y[1] * rs * gn[1]); o.y = cvt_pk_bf16(y[2] * rs * gn[2], y[3] * rs * gn[3]);
        o.z = cvt_pk_bf16(y[4] * rs * gn[4], y[5] * rs * gn[5]); o.w = cvt_pk_bf16(y[6] * rs * gn[6], y[7] * rs * gn[7]);
        *(u32x4*)(proj + r * LDP + COL_GB + ch0) = o;
    }
}

__device__ __forceinline__ void scan_phase(const Params& P) {
    const float* dec = (const float*)(P.ws + WS_DEC); bf16_t* prev = (bf16_t*)(P.ws + WS_TAIL);
    for (int gid = blockIdx.x * 512 + threadIdx.x; gid < NBATCH * 32 * 64 * 32; gid += gridDim.x * 512) {
        const int n4 = gid & 31, p = (gid >> 5) & 63, h = (gid >> 11) & 31, b = gid >> 16;
        f32x4 st = (f32x4){0.f, 0.f, 0.f, 0.f};
        size_t idx = ((size_t)(b * 128) * 32 + h) * 8192 + p * 128 + 4 * n4;
        const float* dp = dec + (b * 128) * 32 + h;
#pragma unroll 8
        for (int c = 0; c < 128; ++c) {
            const u32x2 sw = *(const u32x2*)(prev + idx); const f32x4 sv = (f32x4){bf_lo(sw.x), bf_hi(sw.x), bf_lo(sw.y), bf_hi(sw.y)}; const float d = dp[c * 32];
            st = st * d + sv;
            *(u32x2*)(prev + idx) = (u32x2){cvt_pk_bf16(st.x, st.y), cvt_pk_bf16(st.z, st.w)};
            idx += (size_t)32 * 8192;
        }
    }
}

struct OutRaw { XRows xr; u32x4 rw[7]; bf16_t rawdt; };
__device__ __forceinline__ void ssd_out_load(const Params& P, int unit, OutRaw& r) {
    const int g = unit & 7, c = ((unit >> 3) & 127) + 1, b = unit >> 10;
    const int tid = opaque_tid();
    const bf16_t* proj = (const bf16_t*)(P.ws + WS_PROJ);
    const size_t R0 = (size_t)b * LP + (size_t)c * 128;
    r.rawdt = ssd_dt_load(proj, R0, g);
    ssd_conv_x_load(r.xr, proj, R0, c, g);
    const int c8 = tid & 15, run = tid >> 4, l0 = 4 * run;
    const bf16_t* src = proj + COL_B + 128 * g + 8 * c8;
#pragma unroll
    for (int k = 0; k < 7; ++k) r.rw[k] = *(const u32x4*)(src + (R0 + l0 - 3 + k) * LDP);
}
__device__ __forceinline__ void ssd_out_unit(const Params& P, LAS unsigned char* lds, int unit, OutRaw& raw, int next_unit) {
    const int g = unit & 7, c = ((unit >> 3) & 127) + 1, b = unit >> 10;
    const int tid = opaque_tid(), lane = tid & 63, wid = tid >> 6, fr = lane & 15, fq = lane >> 4;
    bf16_t* proj = (bf16_t*)(P.ws + WS_PROJ);
    const size_t R0 = (size_t)b * LP + (size_t)c * 128;
    const bf16_t* prevg = (const bf16_t*)(P.ws + WS_TAIL) + ((size_t)(b * 128 + (c - 1)) * 32 + 4 * g) * 8192;
    u32x4 pf[2];
#pragma unroll
    for (int i = 0; i < 2; ++i) pf[i] = *(const u32x4*)(prevg + (size_t)(tid + 512 * i) * 8);
    const bf16_t rawdt = raw.rawdt; const XRows& xr = raw.xr; const u32x4 (&rw)[7] = raw.rw;
    const int l = 16 * wid + fr;
    u32x4 crow[4][4];
#pragma unroll
    for (int ks = 0; ks < 4; ++ks)
#pragma unroll
        for (int k = 0; k < 4; ++k) crow[ks][k] = *(const u32x4*)(proj + COL_C + 128 * g + 32 * ks + 8 * fq + (R0 + l - 3 + k) * LDP);
    ssd_dt_prologue(P, lds, rawdt, g);
    ssd_conv_x<false>(P, lds, xr, g);
    {
        const int c8 = tid & 15, run = tid >> 4, n0 = 8 * c8, bc = 2048 + 128 * g + n0, l0 = 4 * run;
        float w[4][8], bb[8];
#pragma unroll
        for (int k = 0; k < 4; ++k) { const f32x4 a = *(const f32x4*)(P.cw + k * 4096 + bc), a2 = *(const f32x4*)(P.cw + k * 4096 + bc + 4);
            w[k][0] = a.x; w[k][1] = a.y; w[k][2] = a.z; w[k][3] = a.w; w[k][4] = a2.x; w[k][5] = a2.y; w[k][6] = a2.z; w[k][7] = a2.w; }
        { const f32x4 a = *(const f32x4*)(P.cb + bc), a2 = *(const f32x4*)(P.cb + bc + 4); bb[0] = a.x; bb[1] = a.y; bb[2] = a.z; bb[3] = a.w; bb[4] = a2.x; bb[5] = a2.y; bb[6] = a2.z; bb[7] = a2.w; }
#pragma unroll
        for (int t = 0; t < 4; ++t) {
            float y[8];
#pragma unroll
            for (int j = 0; j < 8; ++j) y[j] = bb[j];
#pragma unroll
            for (int k = 0; k < 4; ++k) { const u32x4 q = rw[t + k];
                y[0] += w[k][0] * bf_lo(q.x); y[1] += w[k][1] * bf_hi(q.x); y[2] += w[k][2] * bf_lo(q.y); y[3] += w[k][3] * bf_hi(q.y);
                y[4] += w[k][4] * bf_lo(q.z); y[5] += w[k][5] * bf_hi(q.z); y[6] += w[k][6] * bf_lo(q.w); y[7] += w[k][7] * bf_hi(q.w); }
#pragma unroll
            for (int j = 0; j < 8; ++j) y[j] = silu_f(y[j]);
            u32x4 o; o.x = cvt_pk_bf16(y[0], y[1]); o.y = cvt_pk_bf16(y[2], y[3]); o.z = cvt_pk_bf16(y[4], y[5]); o.w = cvt_pk_bf16(y[6], y[7]);
            *(LAS u32x4*)(lds + L_B + (l0 + t) * LROW + n0 * 2) = o;
        }
    }
    if (next_unit >= 0) ssd_out_load(P, next_unit, raw);
    bf16x8 Cf[4];
#pragma unroll
    for (int ks = 0; ks < 4; ++ks) {
        const int n0 = 32 * ks + 8 * fq, cc = 3072 + 128 * g + n0;
        float y[8];
        { const f32x4 a = *(const f32x4*)(P.cb + cc), a2 = *(const f32x4*)(P.cb + cc + 4); y[0] = a.x; y[1] = a.y; y[2] = a.z; y[3] = a.w; y[4] = a2.x; y[5] = a2.y; y[6] = a2.z; y[7] = a2.w; }
#pragma unroll
        for (int k = 0; k < 4; ++k) {
            const u32x4 q = crow[ks][k];
            const f32x4 a = *(const f32x4*)(P.cw + k * 4096 + cc), a2 = *(const f32x4*)(P.cw + k * 4096 + cc + 4);
            y[0] += a.x * bf_lo(q.x); y[1] += a.y * bf_hi(q.x); y[2] += a.z * bf_lo(q.y); y[3] += a.w * bf_hi(q.y);
            y[4] += a2.x * bf_lo(q.z); y[5] += a2.y * bf_hi(q.z); y[6] += a2.z * bf_lo(q.w); y[7] += a2.w * bf_hi(q.w);
        }
#pragma unroll
        for (int j = 0; j < 8; ++j) y[j] = silu_f(y[j]);
        u32x4 o; o.x = cvt_pk_bf16(y[0], y[1]); o.y = cvt_pk_bf16(y[2], y[3]); o.z = cvt_pk_bf16(y[4], y[5]); o.w = cvt_pk_bf16(y[6], y[7]);
        Cf[ks] = __builtin_bit_cast(bf16x8, o);
        asm volatile("" ::: "memory");
    }
#pragma unroll
    for (int i = 0; i < 2; ++i) { const int e = tid + 512 * i; *(LAS u32x4*)(lds + L_P0 + (e >> 4) * LROW + (e & 15) * 16) = pf[i]; }
    __syncthreads();
    f32x4 cbt[8];
    const int wu = __builtin_amdgcn_readfirstlane(wid);
#pragma unroll
    for (int T = 0; T < 8; ++T) { cbt[T] = (f32x4){0.f, 0.f, 0.f, 0.f};
        if (T <= wu)
#pragma unroll
        for (int ks = 0; ks < 4; ++ks) { const bf16x8 af = *(const LAS bf16x8*)(lds + L_B + (16 * T + fr) * LROW + (32 * ks + 8 * fq) * 2);
            cbt[T] = __builtin_amdgcn_mfma_f32_16x16x32_bf16(af, Cf[ks], cbt[T], 0, 0, 0); } }
    u32x2 yr0[4], yr1[4], yr2[4], yr3[4]; float ssq = 0.f;
#pragma unroll
    for (int pt = 0; pt < 4; ++pt) { yr0[pt] = yr1[pt] = yr2[pt] = yr3[pt] = (u32x2){0u, 0u}; }
#pragma unroll 1
    for (int hh = 0; hh < 4; ++hh) {
        if (hh < 3) {
#pragma unroll
            for (int i = 0; i < 2; ++i) pf[i] = *(const u32x4*)(prevg + (size_t)(hh + 1) * 8192 + (size_t)(tid + 512 * i) * 8);
        }
        const LAS float* cs = (const LAS float*)(lds + L_CS) + hh * 128; const LAS float* dt = (const LAS float*)(lds + L_DT) + hh * 128;
        const float csl = cs[l], Dh = P.dsk[4 * g + hh];
        f32x4 yd[4], yo[4];
#pragma unroll
        for (int pt = 0; pt < 4; ++pt) { yd[pt] = (f32x4){0.f, 0.f, 0.f, 0.f}; yo[pt] = (f32x4){0.f, 0.f, 0.f, 0.f}; }
#pragma unroll
        for (int q = 0; q < 4; ++q) if (2 * q <= wu) {
            float pv[8];
#pragma unroll
            for (int hf = 0; hf < 2; ++hf) {
                const int T = 2 * q + hf, s0 = 16 * T + 4 * fq;
                const f32x4 c4 = *(const LAS f32x4*)(cs + s0), d4 = *(const LAS f32x4*)(dt + s0);
#pragma unroll
                for (int r = 0; r < 4; ++r) {
                    const int s = s0 + r;
                    const float e = (s <= l) ? __expf(fminf(csl - c4[r], 0.f)) * d4[r] : 0.f;
                    float v = cbt[T][r] * e; if (s == l) v += Dh;
                    pv[hf * 4 + r] = v;
                }
            }
            u32x4 o; o.x = cvt_pk_bf16(pv[0], pv[1]); o.y = cvt_pk_bf16(pv[2], pv[3]); o.z = cvt_pk_bf16(pv[4], pv[5]); o.w = cvt_pk_bf16(pv[6], pv[7]);
            const bf16x8 pfr = __builtin_bit_cast(bf16x8, o);
#pragma unroll
            for (int pt = 0; pt < 4; ++pt) {
                const LAS unsigned char* xr = lds + L_X + (64 * hh + 16 * pt + fr) * LROW + (32 * q + 4 * fq) * 2;
                const u32x2 lo = *(const LAS u32x2*)xr, hi = *(const LAS u32x2*)(xr + 32);
                const u32x4 xx = (u32x4){lo.x, lo.y, hi.x, hi.y};
                yd[pt] = __builtin_amdgcn_mfma_f32_16x16x32_bf16(__builtin_bit_cast(bf16x8, xx), pfr, yd[pt], 0, 0, 0);
            }
        }
        const int pbuf = (hh & 1) ? L_P1 : L_P0;
#pragma unroll
        for (int ks = 0; ks < 4; ++ks)
#pragma unroll
            for (int pt = 0; pt < 4; ++pt) { const bf16x8 pa = *(const LAS bf16x8*)(lds + pbuf + (16 * pt + fr) * LROW + (32 * ks + 8 * fq) * 2);
                yo[pt] = __builtin_amdgcn_mfma_f32_16x16x32_bf16(pa, Cf[ks], yo[pt], 0, 0, 0); }
        const float el = __expf(csl);
#pragma unroll
        for (int pt = 0; pt < 4; ++pt) {
            const f32x4 v = yd[pt] + yo[pt] * el;
            yr3[pt] = yr2[pt]; yr2[pt] = yr1[pt]; yr1[pt] = yr0[pt]; yr0[pt] = (u32x2){cvt_pk_bf16(v.x, v.y), cvt_pk_bf16(v.z, v.w)};
        }
        if (hh < 3) {
            const int nbuf = (hh & 1) ? L_P0 : L_P1;
#pragma unroll
            for (int i = 0; i < 2; ++i) { const int e = tid + 512 * i; *(LAS u32x4*)(lds + nbuf + (e >> 4) * LROW + (e & 15) * 16) = pf[i]; }
        }
        __syncthreads();
    }
    (void)ssq;
    {
        constexpr int YP = 528;
        LAS unsigned char* stg = lds + L_X + wid * (16 * YP);
#pragma unroll
        for (int hh = 0; hh < 4; ++hh)
#pragma unroll
            for (int pt = 0; pt < 4; ++pt) {
                const u32x2 vp = (hh == 0) ? yr3[pt] : (hh == 1) ? yr2[pt] : (hh == 2) ? yr1[pt] : yr0[pt];
                *(LAS u32x2*)(stg + fr * YP + (64 * hh + 16 * pt + 4 * fq) * 2) = vp;
            }
        const int rsub = lane >> 5, c8 = (lane & 31) * 8;
        const f32x4 ga = *(const f32x4*)(P.sng + 256 * g + c8), gb = *(const f32x4*)(P.sng + 256 * g + c8 + 4);
        u32x4 zr[8];
#pragma unroll
        for (int j = 0; j < 8; ++j) zr[j] = *(const u32x4*)(proj + (R0 + 16 * wid + 2 * j + rsub) * LDP + COL_Z + 256 * g + c8);
#pragma unroll
        for (int j = 0; j < 8; ++j) {
            const u32x4 yv = *(const LAS u32x4*)(stg + (2 * j + rsub) * YP + c8 * 2);
            float v[8];
            v[0] = bf_lo(yv.x) * silu_f(bf_lo(zr[j].x)); v[1] = bf_hi(yv.x) * silu_f(bf_hi(zr[j].x)); v[2] = bf_lo(yv.y) * silu_f(bf_lo(zr[j].y)); v[3] = bf_hi(yv.y) * silu_f(bf_hi(zr[j].y));
            v[4] = bf_lo(yv.z) * silu_f(bf_lo(zr[j].z)); v[5] = bf_hi(yv.z) * silu_f(bf_hi(zr[j].z)); v[6] = bf_lo(yv.w) * silu_f(bf_lo(zr[j].w)); v[7] = bf_hi(yv.w) * silu_f(bf_hi(zr[j].w));
            float ss = ((v[0] * v[0] + v[1] * v[1]) + (v[2] * v[2] + v[3] * v[3])) + ((v[4] * v[4] + v[5] * v[5]) + (v[6] * v[6] + v[7] * v[7]));
            ss += __shfl_xor(ss, 1); ss += __shfl_xor(ss, 2); ss += __shfl_xor(ss, 4); ss += __shfl_xor(ss, 8); ss += __shfl_xor(ss, 16);
            const float rs = rsqrtf(ss * (1.f / 256.f) + EPS);
            u32x4 o; o.x = cvt_pk_bf16(v[0] * rs * ga.x, v[1] * rs * ga.y); o.y = cvt_pk_bf16(v[2] * rs * ga.z, v[3] * rs * ga.w);
            o.z = cvt_pk_bf16(v[4] * rs * gb.x, v[5] * rs * gb.y); o.w = cvt_pk_bf16(v[6] * rs * gb.z, v[7] * rs * gb.w);
            *(u32x4*)(proj + (R0 + 16 * wid + 2 * j + rsub) * LDP + COL_Z + 256 * g + c8) = o;
        }
    }
}

__device__ __forceinline__ void post_mix_phase(const Params& P) {
    const int lane = threadIdx.x & 63, gw = blockIdx.x * 8 + (threadIdx.x >> 6), NGW = gridDim.x * 8;
    const bf16_t* MIX = (const bf16_t*)(P.ws + WS_TAIL); bf16_t* H1N = (bf16_t*)P.out;
    for (int r = gw; r < MR; r += NGW) {
        const f32x4* xr = (const f32x4*)(P.x + (size_t)r * DM) + lane; const u32x2* mb = (const u32x2*)(MIX + (size_t)r * DM) + lane;
        const f32x4* g1 = (const f32x4*)P.g_postmix + lane; const f32x4* g2 = (const f32x4*)P.g_premlp + lane;
        f32x4 v[8]; float s = 0.f;
#pragma unroll
        for (int j = 0; j < 8; ++j) { const u32x2 w = mb[64 * j]; v[j] = (f32x4){bf_lo(w.x), bf_hi(w.x), bf_lo(w.y), bf_hi(w.y)}; s += (v[j].x * v[j].x + v[j].y * v[j].y) + (v[j].z * v[j].z + v[j].w * v[j].w); }
        const float rs = rsqrtf(wave_sum(s) * (1.f / DM) + EPS);
        float s2 = 0.f;
#pragma unroll
        for (int j = 0; j < 8; ++j) { const f32x4 xx = __builtin_nontemporal_load(xr + 64 * j), gg = g1[64 * j]; v[j] = xx + v[j] * rs * gg; s2 += (v[j].x * v[j].x + v[j].y * v[j].y) + (v[j].z * v[j].z + v[j].w * v[j].w); }
        const float rs2 = rsqrtf(wave_sum(s2) * (1.f / DM) + EPS);
        u32x2* o8 = (u32x2*)(H1N + (size_t)r * DM) + lane;
#pragma unroll
        for (int j = 0; j < 8; ++j) { const f32x4 gg = g2[64 * j]; o8[64 * j] = (u32x2){cvt_pk_bf16(v[j].x * rs2 * gg.x, v[j].y * rs2 * gg.y), cvt_pk_bf16(v[j].z * rs2 * gg.z, v[j].w * rs2 * gg.w)}; }
    }
}
__device__ __forceinline__ void final_phase(const Params& P) {
    const int lane = threadIdx.x & 63, gw = blockIdx.x * 8 + (threadIdx.x >> 6), NGW = gridDim.x * 8;
    const bf16_t* FF = (const bf16_t*)(P.ws + WS_FF); const bf16_t* MIX = (const bf16_t*)(P.ws + WS_TAIL);
    for (int r = gw; r < MR; r += NGW) {
        f32x4* orow = (f32x4*)(P.out + (size_t)r * DM) + lane; const f32x4* xr = (const f32x4*)(P.x + (size_t)r * DM) + lane;
        const u32x2* fb = (const u32x2*)(FF + (size_t)r * DM) + lane; const u32x2* mb = (const u32x2*)(MIX + (size_t)r * DM) + lane;
        const f32x4* g1 = (const f32x4*)P.g_postmix + lane; const f32x4* g2 = (const f32x4*)P.g_postmlp + lane;
        f32x4 v[8], m[8]; float s = 0.f, sm = 0.f;
#pragma unroll
        for (int j = 0; j < 8; ++j) { const u32x2 w = __builtin_nontemporal_load(fb + 64 * j); v[j] = (f32x4){bf_lo(w.x), bf_hi(w.x), bf_lo(w.y), bf_hi(w.y)}; s += (v[j].x * v[j].x + v[j].y * v[j].y) + (v[j].z * v[j].z + v[j].w * v[j].w);
            const u32x2 q = __builtin_nontemporal_load(mb + 64 * j); m[j] = (f32x4){bf_lo(q.x), bf_hi(q.x), bf_lo(q.y), bf_hi(q.y)}; sm += (m[j].x * m[j].x + m[j].y * m[j].y) + (m[j].z * m[j].z + m[j].w * m[j].w); }
        const float rs = rsqrtf(wave_sum(s) * (1.f / DM) + EPS), rsm = rsqrtf(wave_sum(sm) * (1.f / DM) + EPS);
#pragma unroll
        for (int j = 0; j < 8; ++j) { const f32x4 xx = __builtin_nontemporal_load(xr + 64 * j), ga = g1[64 * j], gb = g2[64 * j]; __builtin_nontemporal_store((xx + m[j] * rsm * ga) + v[j] * rs * gb, orow + 64 * j); }
    }
}

#define XB_TMO      128
#define XB_XCNT(j)  (256  + 64 * (j))
#define XB_XSUB(j)  (1280 + 64 * (j))
#define XB_XGEN(j)  (2304 + 64 * (j))
#define XB_TOP      3328
#define XB_TOPGEN   3392
#define XCD_BAR_WORDS 3456
#define XB_SPIN_CAP (1u << 18)
__device__ __forceinline__ unsigned xb_ld(unsigned* p)              { return __hip_atomic_load(p, __ATOMIC_RELAXED, __HIP_MEMORY_SCOPE_AGENT); }
__device__ __forceinline__ unsigned xb_add(unsigned* p, unsigned v) { return __hip_atomic_fetch_add(p, v, __ATOMIC_RELAXED, __HIP_MEMORY_SCOPE_AGENT); }
__device__ __forceinline__ unsigned xb_xcc_id() { return (unsigned)__builtin_amdgcn_s_getreg((3 << 11) | 20) & 0xFu; }
#define XB_SPIN(cond, bar) do { unsigned _sp = 0; while (cond) { __builtin_amdgcn_s_sleep(1); \
    if ((++_sp & 255u) == 0u) { if (xb_ld(&(bar)[XB_TMO])) break; if (_sp > XB_SPIN_CAP) { atomicAdd(&(bar)[XB_TMO], 1u); break; } } } } while (0)
struct XcdBarrier { unsigned* bar; unsigned x; volatile LAS unsigned* st; };
__device__ __forceinline__ XcdBarrier xcd_barrier_post(unsigned* bar, volatile LAS unsigned* st) {
    XcdBarrier b; b.bar = bar; b.x = xb_xcc_id(); b.st = st;
    if (threadIdx.x == 0) (void)xb_add(&bar[XB_XCNT(b.x)], 1u);
    return b;
}
__device__ __forceinline__ void xcd_barrier_complete(unsigned* bar, unsigned x, unsigned& nloc, unsigned& nx) {
    const unsigned G = gridDim.x * gridDim.y * gridDim.z;
    unsigned sum, cnt, mine, sp = 0u;
    for (;;) {
        sum = 0u; cnt = 0u; mine = 0u;
#pragma unroll
        for (unsigned j = 0; j < 16; ++j) { const unsigned c = xb_ld(&bar[XB_XCNT(j)]); sum += c; cnt += (c > 0u) ? 1u : 0u; mine = (j == x) ? c : mine; }
        if (sum == G) break;
        __builtin_amdgcn_s_sleep(1);
        if ((++sp & 255u) == 0u) { if (xb_ld(&bar[XB_TMO])) break; if (sp > XB_SPIN_CAP) { atomicAdd(&bar[XB_TMO], 1u); break; } }
    }
    nloc = mine > 0u ? mine : 1u; nx = cnt > 0u ? cnt : 1u;
}
__device__ __forceinline__ void xcd_barrier(const XcdBarrier& b) {
    asm volatile("s_waitcnt vmcnt(0)" ::: "memory");
    __syncthreads();
    if (threadIdx.x == 0) {
        unsigned* bar = b.bar;
        __builtin_amdgcn_s_waitcnt(0);
        unsigned nloc = b.st[0], nx = b.st[1];
        if (nloc == 0u) { xcd_barrier_complete(bar, b.x, nloc, nx); b.st[0] = nloc; b.st[1] = nx; }
        const unsigned old = xb_add(&bar[XB_XSUB(b.x)], 1u);
        const unsigned gen = old / nloc;
        if (old + 1u == (gen + 1u) * nloc) {
            __builtin_amdgcn_fence(__ATOMIC_RELEASE, "agent");
            asm volatile("s_waitcnt vmcnt(0)" ::: "memory");
            const unsigned og = xb_add(&bar[XB_TOP], 1u);
            const unsigned tg = og / nx;
            if (og + 1u == (tg + 1u) * nx) xb_add(&bar[XB_TOPGEN], 1u);
            else XB_SPIN(xb_ld(&bar[XB_TOPGEN]) == tg, bar);
            __builtin_amdgcn_fence(__ATOMIC_ACQUIRE, "agent");
            xb_add(&bar[XB_XGEN(b.x)], 1u);
            asm volatile("s_waitcnt vmcnt(0)" ::: "memory");
        } else {
            XB_SPIN(xb_ld(&bar[XB_XGEN(b.x)]) == gen, bar);
            __builtin_amdgcn_fence(__ATOMIC_ACQUIRE, "agent");
            asm volatile("s_waitcnt vmcnt(0)" ::: "memory");
        }
    }
    __syncthreads();
}

extern __shared__ __attribute__((aligned(16))) unsigned char dyn_lds[];

__global__ void __launch_bounds__(512) hymba_fwd(Params P) {
    cg::grid_group grid = cg::this_grid();
    LAS unsigned char* lds = (LAS unsigned char*)dyn_lds;
    const int G = gridDim.x;
    pg8::StaticOrder S;
    LAS unsigned char* epi_stg = lds + 131072 + (threadIdx.x >> 6) * pg8::EPI_STG_BYTES;
    volatile LAS unsigned* xst = (volatile LAS unsigned*)(lds + LDS_MAIN);
    unsigned* xbar = (unsigned*)(P.ws + WS_BAR);
    if (threadIdx.x == 0) { xst[0] = 0u; xst[1] = 0u; }
    if (blockIdx.x == 0) for (int i = threadIdx.x; i < XCD_BAR_WORDS; i += 512) xbar[i] = 0u;
#ifndef SKIP_P0
    phase0(P, lds);
#endif
#if defined(PROBE_X2) && (PROBE_X2 & 1)
    __syncthreads(); phase0(P, lds);
#endif
    grid.sync();
    const XcdBarrier xb = xcd_barrier_post(xbar, xst);
    { pg8::Gemm gm{(const bf16_t*)P.out, (const bf16_t*)(P.ws + WS_TAIL), TP / 256, NPAD / 256, DM, DM, 0};
      S.init(gm.nM, gm.nN, G, blockIdx.x);
      pg8::EpiInProj E{(bf16_t*)(P.ws + WS_PROJ), epi_stg};
#ifndef SKIP_GEMM
      pg8::gemm_phase(lds, gm, S, E);
#endif
#if defined(PROBE_GEMM2) && (PROBE_GEMM2 & 1)
      __syncthreads();
#ifdef PROBE_SAMETILE
      S.same = true;
#endif
      pg8::gemm_phase<decltype(E), PROBE_NOEPI>(lds, gm, S, E); S.same = false;
#endif
    }
    xcd_barrier(xb);
#ifndef SKIP_P2
    for (int u = blockIdx.x; u < NBATCH * 128 * 8; u += G) ssd_states_unit(P, lds, u);
#endif
#if defined(PROBE_X2) && (PROBE_X2 & 2)
    for (int u = blockIdx.x; u < NBATCH * 128 * 8; u += G) ssd_states_unit(P, lds, u);
#endif
#ifndef SKIP_SC
    for (int t = blockIdx.x * 8 + (threadIdx.x >> 6); t < (MR / 32) * 4; t += G * 8) shortconv_task(P, t, threadIdx.x & 63);
#endif
    xcd_barrier(xb);
#ifndef SKIP_P3
    scan_phase(P);
#endif
#if defined(PROBE_X2) && (PROBE_X2 & 4)
    scan_phase(P);
#endif
    xcd_barrier(xb);
#ifndef SKIP_P4
    {   constexpr int NU = NBATCH * 128 * 8; OutRaw raw; int u = blockIdx.x;
        if (u < NU) ssd_out_load(P, u, raw);
        for (; u < NU; u += G) ssd_out_unit(P, lds, u, raw, (u + G < NU) ? u + G : -1); }
#endif
    xcd_barrier(xb);
    { pg8::Gemm gm{(const bf16_t*)(P.ws + WS_PROJ), (const bf16_t*)(P.ws + WS_WOUT), MR / 256, DM / 256, DMIX, LDP, 1};
      S.init(gm.nM, gm.nN, G, blockIdx.x);
      pg8::EpiBf16<0> E{(bf16_t*)(P.ws + WS_TAIL), DM, epi_stg};
#ifndef SKIP_GEMM
      pg8::gemm_phase(lds, gm, S, E);
#endif
#if defined(PROBE_GEMM2) && (PROBE_GEMM2 & 2)
      __syncthreads();
#ifdef PROBE_SAMETILE
      S.same = true;
#endif
      pg8::gemm_phase<decltype(E), PROBE_NOEPI>(lds, gm, S, E); S.same = false;
#endif
    }
    xcd_barrier(xb);
#ifndef SKIP_P6
    post_mix_phase(P);
#endif
    xcd_barrier(xb);
    { pg8::Gemm gm{(const bf16_t*)P.out, (const bf16_t*)(P.ws + WS_W1), MR / 256, DFF / 256, DM, DM, 0};
      S.init(gm.nM, gm.nN, G, blockIdx.x);
      pg8::EpiBf16<1> E{(bf16_t*)(P.ws + WS_HID), DFF, epi_stg};
#ifndef SKIP_GEMM
      pg8::gemm_phase(lds, gm, S, E);
#endif
#if defined(PROBE_GEMM2) && (PROBE_GEMM2 & 4)
      __syncthreads();
#ifdef PROBE_SAMETILE
      S.same = true;
#endif
      pg8::gemm_phase<decltype(E), PROBE_NOEPI>(lds, gm, S, E); S.same = false;
#endif
    }
    xcd_barrier(xb);
    { pg8::Gemm gm{(const bf16_t*)(P.ws + WS_HID), (const bf16_t*)(P.ws + WS_W2), MR / 256, DM / 256, DFF, DFF, 0};
      S.init(gm.nM, gm.nN, G, blockIdx.x);
      pg8::EpiBf16<0> E{(bf16_t*)(P.ws + WS_FF), DM, epi_stg};
#ifndef SKIP_GEMM
      pg8::gemm_phase(lds, gm, S, E);
#endif
#if defined(PROBE_GEMM2) && (PROBE_GEMM2 & 8)
      __syncthreads();
#ifdef PROBE_SAMETILE
      S.same = true;
#endif
      pg8::gemm_phase<decltype(E), PROBE_NOEPI>(lds, gm, S, E); S.same = false;
#endif
    }
    xcd_barrier(xb);
#ifndef SKIP_P9
    final_phase(P);
#endif
}

extern "C" void kernel_launch(void* const* d_in, const int* in_sizes, int n_in, void* d_out, int out_size, void* d_ws, size_t ws_size, hipStream_t stream) {
    static int grid = 0;
    if (!grid) {
        if (n_in != 18 || ws_size < WS_END) { fprintf(stderr, "kernel_launch: unexpected n_in %d / ws %zu (need %zu)\n", n_in, ws_size, (size_t)WS_END); grid = -1; return; }
        int dev = 0, cus = 0, per_cu = 0;
        (void)hipGetDevice(&dev);
        (void)hipDeviceGetAttribute(&cus, hipDeviceAttributeMultiprocessorCount, dev);
        (void)hipFuncSetAttribute((const void*)hymba_fwd, hipFuncAttributeMaxDynamicSharedMemorySize, LDS_BYTES);
        (void)hipOccupancyMaxActiveBlocksPerMultiprocessor(&per_cu, (const void*)hymba_fwd, 512, LDS_BYTES);
        if (per_cu < 1) { fprintf(stderr, "kernel_launch: occupancy query says %d blocks per CU\n", per_cu); per_cu = 1; }
        grid = cus;
    }
    if (grid < 0) return;
    Params p{};
    const float** f = (const float**)&p;
    for (int i = 0; i < 18; ++i) f[i] = (const float*)d_in[i];
    p.out = (float*)d_out; p.ws = (unsigned char*)d_ws;
    void* args[] = {&p};
    hipError_t e = hipLaunchCooperativeKernel((const void*)hymba_fwd, dim3(grid), dim3(512), args, LDS_BYTES, stream);
    if (e != hipSuccess) fprintf(stderr, "cooperative launch failed: %s (grid %d)\n", hipGetErrorString(e), grid);
}
```

```cpp
#define EPI_NT 1
#define PG8_SP2 true
#define PG8_ALIGN true
#include <hip/hip_runtime.h>
#include <hip/hip_cooperative_groups.h>
#include <cstdio>
namespace cg = cooperative_groups;

#define LAS __attribute__((address_space(3)))
typedef unsigned short bf16_t;
typedef short bf16x8 __attribute__((ext_vector_type(8)));
typedef float f32x4 __attribute__((ext_vector_type(4)));
typedef float f32x2 __attribute__((ext_vector_type(2)));
typedef unsigned u32x4 __attribute__((ext_vector_type(4)));
typedef unsigned u32x2 __attribute__((ext_vector_type(2)));

constexpr int DM = 2048, NBATCH = 2, SEQ = 16384, NMETA = 16;
constexpr int LP = 16512;
constexpr int TP = NBATCH * LP;
constexpr int MR = NBATCH * SEQ;
constexpr int NIN = 12320, NPAD = 12544;
constexpr int LDP = 10496;
constexpr int COL_GB = 0, COL_Z = 2048, COL_U = 4096, COL_X = 6144, COL_B = 8192, COL_C = 9216, COL_DT = 10240;
constexpr int DFF = 8192, DMIX = 4096;
constexpr float EPS = 1e-6f;
constexpr int LDS_SSD = 147456, LDS_EPI = 131072 + 8 * 2304, LDS_MAIN = LDS_EPI > LDS_SSD ? LDS_EPI : LDS_SSD, LDS_BYTES = LDS_MAIN + 64;

constexpr size_t WS_WOUT = 0;
constexpr size_t WS_W1 = WS_WOUT + (size_t)DM * DMIX * 2;
constexpr size_t WS_W2 = WS_W1 + (size_t)DFF * DM * 2;
constexpr size_t WS_PROJ = WS_W2 + (size_t)DM * DFF * 2;
constexpr size_t WS_PROJ_BYTES = (size_t)MR * DFF * 2 + (size_t)MR * DM * 4;
static_assert(WS_PROJ_BYTES >= (size_t)TP * LDP * 2, "proj");
constexpr size_t WS_TAIL = WS_PROJ + WS_PROJ_BYTES;
constexpr size_t WS_TAIL_BYTES = (size_t)MR * DM * 2;
constexpr size_t WS_DEC = WS_TAIL + WS_TAIL_BYTES;
constexpr size_t WS_BAR = WS_DEC + (size_t)NBATCH * 128 * 32 * 4;
constexpr size_t WS_END = WS_BAR + 3456 * 4;
constexpr size_t WS_HID = WS_PROJ;
constexpr size_t WS_FF = WS_PROJ + (size_t)MR * DFF * 2;

struct Params {
    const float *x, *meta, *w_in, *scw, *cng, *cw, *cb, *dtb, *alog, *dsk, *sng, *w_out, *g_premix, *g_postmix, *g_premlp, *g_postmlp, *w1, *w2;
    float* out; unsigned char* ws;
};

__device__ __forceinline__ unsigned cvt_pk_bf16(float lo, float hi) { unsigned r; asm volatile("v_cvt_pk_bf16_f32 %0, %1, %2" : "=v"(r) : "v"(lo), "v"(hi)); return r; }
__device__ __forceinline__ unsigned pk_bf16_sw(float lo, float hi) { unsigned a = __float_as_uint(lo), b = __float_as_uint(hi); a += 0x7FFFu + ((a >> 16) & 1u); b += 0x7FFFu + ((b >> 16) & 1u); return (a >> 16) | (b & 0xffff0000u); }
__device__ __forceinline__ float bf_lo(unsigned w) { return __uint_as_float(w << 16); }
__device__ __forceinline__ float bf_hi(unsigned w) { return __uint_as_float(w & 0xffff0000u); }
__device__ __forceinline__ float bf2f(bf16_t b) { return __uint_as_float(((unsigned)b) << 16); }
__device__ __forceinline__ float wave_sum(float v) {
#pragma unroll
    for (int o = 1; o < 64; o <<= 1) v += __shfl_xor(v, o);
    return v;
}
__device__ __forceinline__ int opaque_tid() { int t = threadIdx.x; asm volatile("" : "+v"(t)); return t; }
__device__ __forceinline__ float silu_f(float v) { return v * __builtin_amdgcn_rcpf(1.0f + __expf(-v)); }
__device__ __forceinline__ float softplus_f(float v) { return fmaxf(v, 0.f) + log1pf(__expf(-fabsf(v))); }

#ifndef PROBE_NOEPI
#define PROBE_NOEPI false
#endif
namespace pg8 {
#ifdef EPI_NT
#define EPI_STORE(p, v) __builtin_nontemporal_store((v), (p))
#else
#define EPI_STORE(p, v) (*(p) = (v))
#endif
constexpr int BM = 256, BK = 64, HALF = 128, HTB = HALF * BK * 2, STAGE_BYTES = 8 * HTB, NXCD = 8, WGM = 4;
#ifndef PG8_ROWMAJOR
#define PG8_ROWMAJOR 1
#endif
#if PG8_ROWMAJOR
__host__ __device__ __forceinline__ int lds_byte(int r, int c) { return r * 128 + ((((c >> 3) ^ ((r >> 1) & 7)) & 7) << 4) + (c & 7) * 2; }
__host__ __device__ __forceinline__ void stage_rc(int b, int& R, int& C) { R = b / 128; const int ch = (b % 128) / 16; C = ((ch ^ ((R >> 1) & 7)) & 7) * 8; }
#else
__host__ __device__ __forceinline__ int lds_byte(int r, int c) { const int st = (r >> 4) * 2 + (c >> 5), rr = r & 15, cc = c & 31, ob = rr * 64 + cc * 2; return st * 1024 + (ob ^ (((ob >> 9) & 1) << 5)); }
__host__ __device__ __forceinline__ void stage_rc(int b, int& R, int& C) { const int st = b / 1024, sb = b % 1024, swz = sb ^ (((sb >> 9) & 1) << 5); R = (st >> 1) * 16 + swz / 64; C = (st & 1) * 32 + (swz % 64) / 2; }
#endif
__host__ __device__ __forceinline__ int perm32(int rho) { const int n = rho >> 4, i = rho & 15; return 8 * (i >> 2) + 4 * n + (i & 3); }

struct Unit { int pm, pn; };
struct Gemm { const bf16_t* A; const bf16_t* Bt; int nM, nN, K, lda, amode; };

struct StaticOrder {
    int nM, nN, nwg, G, c; bool same = false;
    __device__ void init(int nM_, int nN_, int G_, int c_) { nM = nM_; nN = nN_; nwg = nM * nN; G = G_; c = c_; }
    __device__ bool next(int i, Unit& u) const {
        const long L = (long)i * G + c; if (L >= nwg) return false;
        int wgid = (int)L; { const int q = nwg / NXCD, r = nwg % NXCD, xcd = wgid % NXCD, off = wgid / NXCD; wgid = (xcd < r ? xcd * (q + 1) : r * (q + 1) + (xcd - r) * q) + off; }
        const int nig = WGM * nN, gid = wgid / nig, fm = gid * WGM, gsz = (nM - fm) < WGM ? (nM - fm) : WGM;
        u.pm = fm + ((wgid % nig) % gsz); u.pn = (wgid % nig) / gsz;
#ifdef PROBE_SAMETILE
        if (same) { u.pm = 0; u.pn = 0; }
#endif
        return true;
    }
};

struct EpiF32 {
    static constexpr bool PERM = false;
    float* C; int ldc;
    __device__ __forceinline__ void operator()(const f32x4 (&acc)[2][2][4][2], const Unit& u, int wr, int wc, int fr, int fq) const {
        const int row0 = u.pm * BM + wr * 64 + fr, col0 = u.pn * BM + wc * 32 + 4 * fq;
#pragma unroll
        for (int ai = 0; ai < 2; ++ai)
#pragma unroll
            for (int m = 0; m < 4; ++m) { float* rowp = C + (size_t)(row0 + ai * HALF + m * 16) * ldc + col0;
#pragma unroll
                for (int bj = 0; bj < 2; ++bj)
#pragma unroll
                    for (int n = 0; n < 2; ++n) EPI_STORE((f32x4*)(rowp + bj * HALF + n * 16), acc[ai][bj][m][n]); }
    }
};
constexpr int EPI_STG_PITCH = 144, EPI_STG_BYTES = 16 * EPI_STG_PITCH;
__device__ __forceinline__ void epi_store_rows(LAS unsigned char* stg, bf16_t* gbase, size_t ldc, const u32x4& w0, const u32x4& w1, int fr, int fq) {
    *(LAS u32x4*)(stg + fr * EPI_STG_PITCH + fq * 16) = w0;
    *(LAS u32x4*)(stg + fr * EPI_STG_PITCH + (4 + fq) * 16) = w1;
    const int lane = fr + 16 * fq, rr = lane >> 3, cc = lane & 7;
    const u32x4 a = *(const LAS u32x4*)(stg + rr * EPI_STG_PITCH + cc * 16);
    const u32x4 b = *(const LAS u32x4*)(stg + (8 + rr) * EPI_STG_PITCH + cc * 16);
    EPI_STORE((u32x4*)(gbase + (size_t)rr * ldc + cc * 8), a);
    EPI_STORE((u32x4*)(gbase + (size_t)(8 + rr) * ldc + cc * 8), b);
}
template <int ACT  > struct EpiBf16 {
    static constexpr bool PERM = true;
    bf16_t* O; int ldc; LAS unsigned char* stg;
    __device__ __forceinline__ void operator()(const f32x4 (&acc)[2][2][4][2], const Unit& u, int wr, int wc, int fr, int fq) const {
        bf16_t* tile = O + (size_t)(u.pm * BM + wr * 64) * ldc + u.pn * BM + wc * 64;
#pragma unroll
        for (int ai = 0; ai < 2; ++ai)
#pragma unroll
            for (int m = 0; m < 4; ++m) {
                u32x4 w[2];
#pragma unroll
                for (int bj = 0; bj < 2; ++bj) { f32x4 v0 = acc[ai][bj][m][0], v1 = acc[ai][bj][m][1];
                    if (ACT == 1) {
#pragma unroll
                        for (int j = 0; j < 4; ++j) { const float a = fmaxf(v0[j], 0.f), b = fmaxf(v1[j], 0.f); v0[j] = a * a; v1[j] = b * b; } }
                    w[bj].x = cvt_pk_bf16(v0[0], v0[1]); w[bj].y = cvt_pk_bf16(v0[2], v0[3]); w[bj].z = cvt_pk_bf16(v1[0], v1[1]); w[bj].w = cvt_pk_bf16(v1[2], v1[3]); }
                epi_store_rows(stg, tile + (size_t)(ai * HALF + m * 16) * ldc, ldc, w[0], w[1], fr, fq); }
    }
};

struct EpiInProj {
    static constexpr bool PERM = true;
    bf16_t* O; LAS unsigned char* stg;
    __device__ __forceinline__ void operator()(const f32x4 (&acc)[2][2][4][2], const Unit& u, int wr, int wc, int fr, int fq) const {
        const int row0 = u.pm * BM + wr * 64 + fr;
        if (u.pn >= 16 && u.pn < 32) {
            const int col0 = COL_U + 128 * (u.pn - 16) + wc * 32 + 8 * fq;
#pragma unroll
            for (int ai = 0; ai < 2; ++ai)
#pragma unroll
                for (int m = 0; m < 4; ++m) { bf16_t* rowp = O + (size_t)(row0 + ai * HALF + m * 16) * LDP + col0;
                    const f32x4 v0 = acc[ai][0][m][0] * acc[ai][1][m][0], v1 = acc[ai][0][m][1] * acc[ai][1][m][1];
                    u32x4 w; w.x = cvt_pk_bf16(v0[0], v0[1]); w.y = cvt_pk_bf16(v0[2], v0[3]); w.z = cvt_pk_bf16(v1[0], v1[1]); w.w = cvt_pk_bf16(v1[2], v1[3]);
                    EPI_STORE((u32x4*)rowp, w); }
        } else {
            bf16_t* tile = O + (size_t)(u.pm * BM + wr * 64) * LDP + (u.pn < 16 ? 256 * u.pn : COL_X + 256 * (u.pn - 32)) + wc * 64;
#pragma unroll
            for (int ai = 0; ai < 2; ++ai)
#pragma unroll
                for (int m = 0; m < 4; ++m) {
                    u32x4 w[2];
#pragma unroll
                    for (int bj = 0; bj < 2; ++bj) { const f32x4 v0 = acc[ai][bj][m][0], v1 = acc[ai][bj][m][1];
                        w[bj].x = cvt_pk_bf16(v0[0], v0[1]); w[bj].y = cvt_pk_bf16(v0[2], v0[3]); w[bj].z = cvt_pk_bf16(v1[0], v1[1]); w[bj].w = cvt_pk_bf16(v1[2], v1[3]); }
                    epi_store_rows(stg, tile + (size_t)(ai * HALF + m * 16) * LDP, LDP, w[0], w[1], fr, fq); }
        }
    }
};
#ifndef PG8_SP2
#define PG8_SP2 false
#endif
#ifndef PG8_ALIGN
#define PG8_ALIGN false
#endif
template <class Epi, bool NOEPI = false, bool SP2 = PG8_SP2, bool ALIGN_EPI = PG8_ALIGN>
__device__ __forceinline__ void gemm_phase(LAS unsigned char* lds, const Gemm g, const StaticOrder& S, const Epi& E) {
    const int tid = opaque_tid(), wid = __builtin_amdgcn_readfirstlane(tid >> 6), lane = tid & 63, wr = wid >> 2, wc = wid & 3, fr = lane & 15, fq = lane >> 4;
    const int K = g.K, nt = K / BK, lda = g.lda;
    unsigned voffA[2], voffB[2], voffB1[2];
#pragma unroll
    for (int i = 0; i < 2; ++i) { int R, C; stage_rc(tid * 16 + i * 8192, R, C); const int Rb = Epi::PERM ? ((R & ~31) + perm32(R & 31)) : R;
        const int Rb0 = Epi::PERM ? (64 * (R >> 5) + perm32(R & 31)) : R, Rb1 = Epi::PERM ? (64 * (R >> 5) + 32 + perm32(R & 31)) : (HALF + R); (void)Rb;
        voffA[i] = (unsigned)(R * lda + C) * 2u; voffB[i] = (unsigned)(Rb0 * K + C) * 2u; voffB1[i] = (unsigned)(Rb1 * K + C) * 2u; }
    const size_t kstep = (size_t)(BK * 2);
    const size_t hstepA = (size_t)HALF * lda * 2, hstepB = (size_t)HALF * K * 2;
    const unsigned ldsw = (unsigned)wid * 1024u;
    const int aoff[2] = {lds_byte(wr * 64 + fr, fq * 8), lds_byte(wr * 64 + fr, 32 + fq * 8)}, boff[2] = {lds_byte(wc * 32 + fr, fq * 8), lds_byte(wc * 32 + fr, 32 + fq * 8)};
#define PG8_SA(b, h) (((b) * 2 + (h)) * HTB)
#define PG8_SB(b, h) ((4 + (b) * 2 + (h)) * HTB)
#define PG8_STAGE(bufoff, gbase, voff) do { _Pragma("unroll") for (int _i = 0; _i < 2; ++_i) \
        __builtin_amdgcn_global_load_lds((const unsigned*)((const char*)(gbase) + (voff)[_i]), (LAS unsigned*)(lds + (bufoff) + ldsw + _i * 8192), 16, 0, 0); } while (0)
#define PG8_LDA(dst, b, h) do { _Pragma("unroll") for (int m = 0; m < 4; ++m) _Pragma("unroll") for (int k = 0; k < 2; ++k) dst[m][k] = *(const LAS bf16x8*)(lds + PG8_SA(b, h) + aoff[k] + m * 2048); } while (0)
#define PG8_LDB(dst, b, h) do { _Pragma("unroll") for (int n = 0; n < 2; ++n) _Pragma("unroll") for (int k = 0; k < 2; ++k) dst[n][k] = *(const LAS bf16x8*)(lds + PG8_SB(b, h) + boff[k] + n * 2048); } while (0)
#define PG8_MMA(ai, bj, At, Bt) do { __builtin_amdgcn_s_setprio(1); _Pragma("unroll") for (int m = 0; m < 4; ++m) _Pragma("unroll") for (int n = 0; n < 2; ++n) _Pragma("unroll") for (int k = 0; k < 2; ++k) \
        acc[ai][bj][m][n] = __builtin_amdgcn_mfma_f32_16x16x32_bf16(Bt[n][k], At[m][k], acc[ai][bj][m][n], 0, 0, 0); __builtin_amdgcn_s_setprio(0); } while (0)
#define PG8_WAIT_V(n) asm volatile("s_waitcnt vmcnt(" #n ")" ::: "memory")
#define PG8_WAIT_L(n) asm volatile("s_waitcnt lgkmcnt(" #n ")" ::: "memory")
#define PG8_BAR __builtin_amdgcn_s_barrier()
#define PG8_SCHED __builtin_amdgcn_sched_barrier(0)
#define PG8_AROW(pm) ((size_t)((pm) * BM + (g.amode ? 128 + 128 * ((pm) >> 6) : 0)))
    Unit cur, nxt; int ui = 0;
    if (!S.next(0, cur)) return;
#ifdef STAGGER_TICKS
#ifndef STAGGER_XCD
#define STAGGER_XCD 0
#endif
    { const unsigned long long t0 = __builtin_amdgcn_s_memrealtime(), dl = (unsigned long long)(STAGGER_XCD ? (S.c & 7) : (S.c >> 3)) * STAGGER_TICKS;
      while (__builtin_amdgcn_s_memrealtime() - t0 < dl) __builtin_amdgcn_s_sleep(8); }
#endif
    f32x4 acc[2][2][4][2];
#pragma unroll
    for (int a = 0; a < 2; ++a)
#pragma unroll
        for (int b = 0; b < 2; ++b)
#pragma unroll
            for (int m = 0; m < 4; ++m)
#pragma unroll
                for (int n = 0; n < 2; ++n) acc[a][b][m][n] = (f32x4){0.f, 0.f, 0.f, 0.f};
    bf16x8 At[4][2], B0[2][2], B1[2][2];
    const char* cA = (const char*)g.A + PG8_AROW(cur.pm) * lda * 2; const char* cB = (const char*)g.Bt + (size_t)cur.pn * BM * K * 2;
    if constexpr (SP2) {
        PG8_STAGE(PG8_SB(0, 0), cB, voffB); PG8_STAGE(PG8_SB(0, 1), cB, voffB1); PG8_STAGE(PG8_SA(0, 0), cA, voffA); PG8_STAGE(PG8_SA(0, 1), cA + hstepA, voffA);
        if (wr == 1) PG8_BAR;
        PG8_WAIT_V(2); PG8_BAR;
        PG8_STAGE(PG8_SB(1, 0), cB + kstep, voffB); PG8_STAGE(PG8_SA(1, 0), cA + kstep, voffA); PG8_STAGE(PG8_SB(1, 1), cB + kstep, voffB1);
        PG8_WAIT_V(6); PG8_BAR;
    } else {
    PG8_STAGE(PG8_SB(0, 0), cB, voffB); PG8_STAGE(PG8_SA(0, 0), cA, voffA); PG8_STAGE(PG8_SB(0, 1), cB, voffB1); PG8_STAGE(PG8_SA(0, 1), cA + hstepA, voffA);
    if (wr == 1) PG8_BAR;
    PG8_WAIT_V(4); PG8_BAR;
    PG8_STAGE(PG8_SB(1, 0), cB + kstep, voffB); PG8_STAGE(PG8_SA(1, 0), cA + kstep, voffA); PG8_STAGE(PG8_SB(1, 1), cB + kstep, voffB1);
    PG8_WAIT_V(6); PG8_BAR;
    }
    for (;;) {
        const bool has_next = S.next(ui + 1, nxt);
        const char* nA = has_next ? (const char*)g.A + PG8_AROW(nxt.pm) * lda * 2 : cA; const char* nB = has_next ? (const char*)g.Bt + (size_t)nxt.pn * BM * K * 2 : cB;
        for (int t = 0; t < nt; t += 2) {
            const bool last = (t == nt - 2);
            const char* a1 = cA + (size_t)(t + 1) * kstep;
            const char* a2 = last ? nA : cA + (size_t)(t + 2) * kstep; const char* b2 = last ? nB : cB + (size_t)(t + 2) * kstep;
            const char* a3 = a2 + kstep; const char* b3 = b2 + kstep;
            if constexpr (SP2) {
            PG8_LDB(B0, 0, 0); PG8_LDB(B1, 0, 1); PG8_SCHED; PG8_LDA(At, 0, 0); PG8_STAGE(PG8_SA(1, 1), a1 + hstepA, voffA);
            PG8_WAIT_V(8); PG8_WAIT_L(0); PG8_BAR; PG8_MMA(0, 0, At, B0); PG8_MMA(0, 1, At, B1); PG8_BAR; PG8_SCHED;
            PG8_LDA(At, 0, 1); PG8_STAGE(PG8_SB(0, 0), b2, voffB); PG8_STAGE(PG8_SB(0, 1), b2, voffB1); PG8_STAGE(PG8_SA(0, 0), a2, voffA);
            PG8_WAIT_V(8); PG8_WAIT_L(0); PG8_BAR; PG8_MMA(1, 0, At, B0); PG8_MMA(1, 1, At, B1); PG8_BAR; PG8_SCHED;
            PG8_LDB(B0, 1, 0); PG8_LDB(B1, 1, 1); PG8_SCHED; PG8_LDA(At, 1, 0); PG8_STAGE(PG8_SA(0, 1), a2 + hstepA, voffA);
            PG8_WAIT_V(8); PG8_WAIT_L(0); PG8_BAR; PG8_MMA(0, 0, At, B0); PG8_MMA(0, 1, At, B1); PG8_BAR; PG8_SCHED;
            PG8_LDA(At, 1, 1); PG8_STAGE(PG8_SB(1, 0), b3, voffB); PG8_STAGE(PG8_SB(1, 1), b3, voffB1); PG8_STAGE(PG8_SA(1, 0), a3, voffA);
            PG8_WAIT_V(8); PG8_WAIT_L(0); PG8_BAR; PG8_MMA(1, 0, At, B0); PG8_MMA(1, 1, At, B1); PG8_BAR; PG8_SCHED;
            } else {
            PG8_LDB(B0, 0, 0); PG8_SCHED; PG8_LDA(At, 0, 0); PG8_STAGE(PG8_SA(1, 1), a1 + hstepA, voffA);
            PG8_WAIT_L(8); PG8_BAR; PG8_WAIT_L(0); PG8_MMA(0, 0, At, B0); PG8_BAR; PG8_SCHED;
            PG8_LDB(B1, 0, 1); PG8_STAGE(PG8_SB(0, 0), b2, voffB);
            PG8_BAR; PG8_WAIT_L(0); PG8_MMA(0, 1, At, B1); PG8_BAR;
            PG8_LDA(At, 0, 1); PG8_STAGE(PG8_SA(0, 0), a2, voffA);
            PG8_BAR; PG8_WAIT_L(0); PG8_MMA(1, 0, At, B0); PG8_BAR; PG8_SCHED;
            PG8_STAGE(PG8_SB(0, 1), b2, voffB1);
            PG8_WAIT_V(6); PG8_BAR; PG8_MMA(1, 1, At, B1); PG8_BAR;
            PG8_LDB(B0, 1, 0); PG8_SCHED; PG8_LDA(At, 1, 0); PG8_STAGE(PG8_SA(0, 1), a2 + hstepA, voffA);
            PG8_WAIT_L(8); PG8_BAR; PG8_WAIT_L(0); PG8_MMA(0, 0, At, B0); PG8_BAR; PG8_SCHED;
            PG8_LDB(B1, 1, 1); PG8_STAGE(PG8_SB(1, 0), b3, voffB);
            PG8_BAR; PG8_WAIT_L(0); PG8_MMA(0, 1, At, B1); PG8_BAR;
            PG8_LDA(At, 1, 1); PG8_STAGE(PG8_SA(1, 0), a3, voffA);
            PG8_BAR; PG8_WAIT_L(0); PG8_MMA(1, 0, At, B0); PG8_BAR; PG8_SCHED;
            PG8_STAGE(PG8_SB(1, 1), b3, voffB1);
            PG8_WAIT_V(6); PG8_BAR; PG8_MMA(1, 1, At, B1); PG8_BAR;
            }
        }
        if constexpr (ALIGN_EPI) { if (wr == 0) PG8_BAR; }
        if (!NOEPI) E(acc, cur, wr, wc, fr, fq);
        else { float sink = 0.f; _Pragma("unroll") for (int a = 0; a < 2; ++a) _Pragma("unroll") for (int b = 0; b < 2; ++b) _Pragma("unroll") for (int m = 0; m < 4; ++m) _Pragma("unroll") for (int n = 0; n < 2; ++n) sink += acc[a][b][m][n][0] + acc[a][b][m][n][1] + acc[a][b][m][n][2] + acc[a][b][m][n][3]; if (sink == 12345.678f) *(float*)g.A = sink; }
        if (!has_next) break;
#pragma unroll
        for (int a = 0; a < 2; ++a)
#pragma unroll
            for (int b = 0; b < 2; ++b)
#pragma unroll
                for (int m = 0; m < 4; ++m)
#pragma unroll
                    for (int n = 0; n < 2; ++n) acc[a][b][m][n] = (f32x4){0.f, 0.f, 0.f, 0.f};
        cur = nxt; cA = nA; cB = nB; ++ui;
        if constexpr (ALIGN_EPI) { if (wr == 1) PG8_BAR; }
    }
    PG8_WAIT_V(0);
    if constexpr (!ALIGN_EPI) { if (wr == 0) PG8_BAR; }
    PG8_BAR;
#undef PG8_SA
#undef PG8_SB
#undef PG8_STAGE
#undef PG8_LDA
#undef PG8_LDB
#undef PG8_MMA
#undef PG8_WAIT_V
#undef PG8_WAIT_L
#undef PG8_BAR
#undef PG8_SCHED
#undef PG8_AROW
}
}

__device__ __forceinline__ void p0_transpose_item(const float* W, int K, int N, bf16_t* WT, int drow0, int scol0, int k0, LAS float* scr, int lane) {
    if (scol0 >= 0) {
#pragma unroll 8
        for (int i = 0; i < 32; ++i) { const int kk = 2 * i + (lane >> 5); scr[kk * 33 + (lane & 31)] = W[(size_t)(k0 + kk) * N + scol0 + (lane & 31)]; }
    } else {
#pragma unroll 8
        for (int i = 0; i < 32; ++i) { const int kk = 2 * i + (lane >> 5); scr[kk * 33 + (lane & 31)] = 0.f; }
    }
    asm volatile("s_waitcnt lgkmcnt(0)" ::: "memory");
    const int c = lane & 7;
#pragma unroll
    for (int j = 0; j < 4; ++j) { const int n = (lane >> 3) + 8 * j; const LAS float* s = scr + (8 * c) * 33 + n;
        u32x4 o; o.x = cvt_pk_bf16(s[0 * 33], s[1 * 33]); o.y = cvt_pk_bf16(s[2 * 33], s[3 * 33]); o.z = cvt_pk_bf16(s[4 * 33], s[5 * 33]); o.w = cvt_pk_bf16(s[6 * 33], s[7 * 33]);
        *(u32x4*)(WT + (size_t)(drow0 + n) * K + k0 + 8 * c) = o; }
    asm volatile("s_waitcnt lgkmcnt(0)" ::: "memory");
}
__device__ __forceinline__ int win_src_col(int n) {
    if (n < 2048) return n;
    if (n < 4096) return 6144 + (n - 2048);
    if (n < 8192) { const int m = n - 4096, t = m >> 8, j = m & 255, wc = j >> 6, bj = (j >> 5) & 1; return (bj ? 4096 : 2048) + 128 * t + 32 * wc; }
    if (n < NIN) return n;
    return -1;
}
__device__ __forceinline__ void phase0(const Params& P, LAS unsigned char* lds) {
    const int tid = opaque_tid(), lane = tid & 63, wave = tid >> 6;
    LAS float* scr = (LAS float*)(lds + wave * 16384);
    const int gw = blockIdx.x * 8 + wave, NGW = gridDim.x * 8;
    bf16_t* WinT = (bf16_t*)(P.ws + WS_TAIL); bf16_t* WoutT = (bf16_t*)(P.ws + WS_WOUT); bf16_t* W1T = (bf16_t*)(P.ws + WS_W1); bf16_t* W2T = (bf16_t*)(P.ws + WS_W2);
    constexpr int I_IN = (DM / 64) * (NPAD / 32), I_OUT = (DMIX / 64) * (DM / 32), I_1 = (DM / 64) * (DFF / 32), I_2 = (DFF / 64) * (DM / 32);
    for (int it = gw; it < I_IN + I_OUT + I_1 + I_2; it += NGW) {
        int r = it;
        if (r < I_IN) { const int nb = r % (NPAD / 32), kb = r / (NPAD / 32); p0_transpose_item(P.w_in, DM, NIN, WinT, nb * 32, win_src_col(nb * 32), kb * 64, scr, lane); continue; } r -= I_IN;
        if (r < I_OUT) { const int nb = r % (DM / 32), kb = r / (DM / 32); p0_transpose_item(P.w_out, DMIX, DM, WoutT, nb * 32, nb * 32, kb * 64, scr, lane); continue; } r -= I_OUT;
        if (r < I_1) { const int nb = r % (DFF / 32), kb = r / (DFF / 32); p0_transpose_item(P.w1, DM, DFF, W1T, nb * 32, nb * 32, kb * 64, scr, lane); continue; } r -= I_1;
        { const int nb = r % (DM / 32), kb = r / (DM / 32); p0_transpose_item(P.w2, DFF, DM, W2T, nb * 32, nb * 32, kb * 64, scr, lane); }
    }
    bf16_t* HN = (bf16_t*)P.out;
    for (int r = gw; r < TP; r += NGW) {
        const int b = r / LP, p = r % LP;
        u32x2* o8 = (u32x2*)(HN + (size_t)r * DM) + lane;
        if (p < 112) {
#pragma unroll
            for (int j = 0; j < 8; ++j) o8[64 * j] = (u32x2){0u, 0u};
            continue;
        }
        const float* src = (p < 128) ? P.meta + (size_t)(p - 112) * DM : P.x + ((size_t)b * SEQ + (p - 128)) * DM;
        const f32x4* xr = (const f32x4*)src + lane; const f32x4* gr = (const f32x4*)P.g_premix + lane;
        f32x4 v[8]; float s = 0.f;
#pragma unroll
        for (int j = 0; j < 8; ++j) { v[j] = __builtin_nontemporal_load(xr + 64 * j); s += (v[j].x * v[j].x + v[j].y * v[j].y) + (v[j].z * v[j].z + v[j].w * v[j].w); }
        const float rs = rsqrtf(wave_sum(s) * (1.f / DM) + EPS);
#pragma unroll
        for (int j = 0; j < 8; ++j) { const f32x4 gg = gr[64 * j]; o8[64 * j] = (u32x2){cvt_pk_bf16(v[j].x * rs * gg.x, v[j].y * rs * gg.y), cvt_pk_bf16(v[j].z * rs * gg.z, v[j].w * rs * gg.w)}; }
    }
}

constexpr int LROW = 272;
constexpr int L_CS = 0, L_DT = 2048, L_WG = 4096, L_TOT = 6144, L_X = 8192, L_B = L_X + 256 * LROW, L_P0 = L_B + 128 * LROW, L_P1 = L_P0 + 64 * LROW;
static_assert(L_P1 + 64 * LROW <= LDS_SSD, "lds");

__device__ __forceinline__ bf16_t ssd_dt_load(const bf16_t* proj, size_t R0, int g) {
    const int tid = opaque_tid(), hh = tid >> 7, l = tid & 127, head = 4 * g + hh;
    return proj[(R0 + l) * LDP + COL_DT + head];
}
struct ConvW2 { float w0[4], w1[4], b0, b1; };
struct DtW { float dtb, nega; };
__device__ __forceinline__ DtW ssd_dt_weights(const Params& P, int g) { const int head = 4 * g + (opaque_tid() >> 7); DtW d; d.dtb = P.dtb[head]; d.nega = -__expf(P.alog[head]); return d; }
__device__ __forceinline__ ConvW2 ssd_conv_weights2(const Params& P, int idx) { ConvW2 c;
#pragma unroll
    for (int k = 0; k < 4; ++k) { c.w0[k] = P.cw[k * 4096 + idx]; c.w1[k] = P.cw[k * 4096 + idx + 1]; }
    c.b0 = P.cb[idx]; c.b1 = P.cb[idx + 1]; return c; }
__device__ __forceinline__ void ssd_dt_prologue(LAS unsigned char* lds, bf16_t rawb, const DtW dw) {
    const int tid = opaque_tid(), lane = tid & 63, wid = tid >> 6, hh = tid >> 7, l = tid & 127;
    LAS float* cs = (LAS float*)(lds + L_CS); LAS float* dt = (LAS float*)(lds + L_DT); LAS float* tot = (LAS float*)(lds + L_TOT);
    const float raw = bf2f(rawb);
    const float dtv = softplus_f(raw + dw.dtb);
    float s = dw.nega * dtv;
#pragma unroll
    for (int o = 1; o < 64; o <<= 1) { const float t = __shfl_up(s, o); if (lane >= o) s += t; }
    if (lane == 63) tot[wid] = s;
    __syncthreads();
    if (wid & 1) s += tot[wid - 1];
    cs[hh * 128 + l] = s; dt[hh * 128 + l] = dtv;
    __syncthreads();
}

struct XRows { unsigned w[35]; };
__device__ __forceinline__ void ssd_conv_x_load(XRows& xr, const bf16_t* proj, size_t R0, int c, int g) {
    const int tid = opaque_tid(), cp = tid & 127, run = tid >> 7;
    const bf16_t* src = proj + COL_X + 256 * g + 2 * cp;
    const int l0 = 32 * run;
#pragma unroll
    for (int k = 0; k < 35; ++k) { const int li = l0 - 3 + k; xr.w[k] = (c > 0 || li >= 0) ? *(const unsigned*)(src + (size_t)((long)R0 + li) * LDP) : 0u; }
}
template <bool SCALE>
__device__ __forceinline__ void ssd_conv_x(LAS unsigned char* lds, const XRows& xr, const ConvW2& cw2) {
    const int tid = opaque_tid(), cp = tid & 127, run = tid >> 7, ch = 2 * cp, hh = cp >> 5;
    const float (&w0)[4] = cw2.w0; const float (&w1)[4] = cw2.w1; const float b0 = cw2.b0, b1 = cw2.b1;
    const LAS float* wg = (const LAS float*)(lds + L_WG) + hh * 128;
    const int l0 = 32 * run;
#pragma unroll
    for (int i = 0; i < 32; i += 8) {
        float o0[8], o1[8];
#pragma unroll
        for (int j = 0; j < 8; ++j) {
            const int t = i + j;
            float y0 = b0 + w0[0] * bf_lo(xr.w[t]) + w0[1] * bf_lo(xr.w[t + 1]) + w0[2] * bf_lo(xr.w[t + 2]) + w0[3] * bf_lo(xr.w[t + 3]);
            float y1 = b1 + w1[0] * bf_hi(xr.w[t]) + w1[1] * bf_hi(xr.w[t + 1]) + w1[2] * bf_hi(xr.w[t + 2]) + w1[3] * bf_hi(xr.w[t + 3]);
            y0 = silu_f(y0); y1 = silu_f(y1);
            if (SCALE) { const float sc = wg[l0 + t]; y0 *= sc; y1 *= sc; }
            o0[j] = y0; o1[j] = y1;
        }
        u32x4 q0, q1;
        q0.x = cvt_pk_bf16(o0[0], o0[1]); q0.y = cvt_pk_bf16(o0[2], o0[3]); q0.z = cvt_pk_bf16(o0[4], o0[5]); q0.w = cvt_pk_bf16(o0[6], o0[7]);
        q1.x = cvt_pk_bf16(o1[0], o1[1]); q1.y = cvt_pk_bf16(o1[2], o1[3]); q1.z = cvt_pk_bf16(o1[4], o1[5]); q1.w = cvt_pk_bf16(o1[6], o1[7]);
        *(LAS u32x4*)(lds + L_X + ch * LROW + (l0 + i) * 2) = q0;
        *(LAS u32x4*)(lds + L_X + (ch + 1) * LROW + (l0 + i) * 2) = q1;
    }
}

struct StatesRaw { XRows xr; unsigned bwv[19]; bf16_t rawdt; };
struct StatesW { ConvW2 xw, bw; DtW dw; };
__device__ __forceinline__ void ssd_states_load(const Params& P, int unit, StatesRaw& r) {
    const int g = unit & 7, c = (unit >> 3) & 127, b = unit >> 10;
    const int tid = opaque_tid();
    const bf16_t* proj = (const bf16_t*)(P.ws + WS_PROJ);
    const size_t R0 = (size_t)b * LP + (size_t)c * 128;
    r.rawdt = ssd_dt_load(proj, R0, g);
    ssd_conv_x_load(r.xr, proj, R0, c, g);
    const int cp = tid & 63, run = tid >> 6, l0 = 16 * run;
    const bf16_t* src = proj + COL_B + 128 * g + 2 * cp;
#pragma unroll
    for (int k = 0; k < 19; ++k) { const int li = l0 - 3 + k; r.bwv[k] = (c > 0 || li >= 0) ? *(const unsigned*)(src + (size_t)((long)R0 + li) * LDP) : 0u; }
}
__device__ __forceinline__ void ssd_states_unit(const Params& P, LAS unsigned char* lds, int unit, StatesRaw& raw, const StatesW& W, int next_unit) {
    const int g = unit & 7, c = (unit >> 3) & 127, b = unit >> 10;
    const int tid = opaque_tid(), lane = tid & 63, wid = tid >> 6, fr = lane & 15, fq = lane >> 4;
    const XRows& xr = raw.xr; const unsigned (&bwv)[19] = raw.bwv;
    ssd_dt_prologue(lds, raw.rawdt, W.dw);
    {
        const int hh = tid >> 7, l = tid & 127;
        const LAS float* cs = (const LAS float*)(lds + L_CS) + hh * 128; const LAS float* dt = (const LAS float*)(lds + L_DT) + hh * 128;
        const float ce = cs[127];
        float w = dt[l] * __expf(ce - cs[l]);
        if (c == 0 && l < 112) w = 0.f;
        ((LAS float*)(lds + L_WG))[hh * 128 + l] = w;
        if (l == 127) ((float*)(P.ws + WS_DEC))[(b * 128 + c) * 32 + 4 * g + hh] = __expf(ce);
    }
    __syncthreads();
    ssd_conv_x<true>(lds, xr, W.xw);
    {
        const int cp = tid & 63, run = tid >> 6, n0 = 2 * cp;
        const float (&w0)[4] = W.bw.w0; const float (&w1)[4] = W.bw.w1; const float b0 = W.bw.b0, b1 = W.bw.b1;
        const int l0 = 16 * run;
#pragma unroll
        for (int i = 0; i < 16; i += 8) {
            float o0[8], o1[8];
#pragma unroll
            for (int j = 0; j < 8; ++j) {
                const int t = i + j;
                o0[j] = silu_f(b0 + w0[0] * bf_lo(bwv[t]) + w0[1] * bf_lo(bwv[t + 1]) + w0[2] * bf_lo(bwv[t + 2]) + w0[3] * bf_lo(bwv[t + 3]));
                o1[j] = silu_f(b1 + w1[0] * bf_hi(bwv[t]) + w1[1] * bf_hi(bwv[t + 1]) + w1[2] * bf_hi(bwv[t + 2]) + w1[3] * bf_hi(bwv[t + 3]));
            }
            u32x4 q0, q1;
            q0.x = cvt_pk_bf16(o0[0], o0[1]); q0.y = cvt_pk_bf16(o0[2], o0[3]); q0.z = cvt_pk_bf16(o0[4], o0[5]); q0.w = cvt_pk_bf16(o0[6], o0[7]);
            q1.x = cvt_pk_bf16(o1[0], o1[1]); q1.y = cvt_pk_bf16(o1[2], o1[3]); q1.z = cvt_pk_bf16(o1[4], o1[5]); q1.w = cvt_pk_bf16(o1[6], o1[7]);
            *(LAS u32x4*)(lds + L_B + n0 * LROW + (l0 + i) * 2) = q0;
            *(LAS u32x4*)(lds + L_B + (n0 + 1) * LROW + (l0 + i) * 2) = q1;
        }
    }
    if (next_unit >= 0) ssd_states_load(P, next_unit, raw);
    __syncthreads();
    f32x4 acc[2][8];
#pragma unroll
    for (int i = 0; i < 2; ++i)
#pragma unroll
        for (int nt = 0; nt < 8; ++nt) acc[i][nt] = (f32x4){0.f, 0.f, 0.f, 0.f};
#pragma unroll
    for (int ks = 0; ks < 4; ++ks) {
        bf16x8 xf[2];
#pragma unroll
        for (int i = 0; i < 2; ++i) xf[i] = *(const LAS bf16x8*)(lds + L_X + (16 * (2 * wid + i) + fr) * LROW + (32 * ks + 8 * fq) * 2);
#pragma unroll
        for (int nt = 0; nt < 8; ++nt) {
            const bf16x8 bfr = *(const LAS bf16x8*)(lds + L_B + (16 * nt + fr) * LROW + (32 * ks + 8 * fq) * 2);
#pragma unroll
            for (int i = 0; i < 2; ++i) acc[i][nt] = __builtin_amdgcn_mfma_f32_16x16x32_bf16(bfr, xf[i], acc[i][nt], 0, 0, 0);
        }
    }
    __syncthreads();
    {
        LAS unsigned char* stg = lds + L_X + wid * (32 * LROW);
#pragma unroll
        for (int i = 0; i < 2; ++i)
#pragma unroll
            for (int nt = 0; nt < 8; ++nt) { const f32x4 a = acc[i][nt]; *(LAS u32x2*)(stg + (16 * i + fr) * LROW + (16 * nt + 4 * fq) * 2) = (u32x2){pk_bf16_sw(a.x, a.y), pk_bf16_sw(a.z, a.w)}; }
        bf16_t* Sg = (bf16_t*)(P.ws + WS_TAIL) + ((size_t)(b * 128 + c) * 32 + 4 * g + (wid >> 1)) * 8192 + (size_t)((32 * wid) & 63) * 128;
        const int rsub = lane >> 4, ck = lane & 15;
#pragma unroll
        for (int j = 0; j < 8; ++j) { const u32x4 v = *(const LAS u32x4*)(stg + (4 * j + rsub) * LROW + ck * 16); *(u32x4*)(Sg + (4 * j + rsub) * 128 + ck * 8) = v; }
    }
}

__device__ __forceinline__ void shortconv_task(const Params& P, int task, int lane) {
    bf16_t* proj = (bf16_t*)(P.ws + WS_PROJ);
    const int q = task & 3, run = task >> 2, m0 = run * 32;
    const size_t row0 = (size_t)m0 + 128 + 128 * (m0 >> 14);
    const int ch0 = 512 * q + 8 * lane;
    float w[3][8], gn[8];
#pragma unroll
    for (int k = 0; k < 3; ++k) { const f32x4 a = *(const f32x4*)(P.scw + k * 2048 + ch0), bq = *(const f32x4*)(P.scw + k * 2048 + ch0 + 4);
        w[k][0] = a.x; w[k][1] = a.y; w[k][2] = a.z; w[k][3] = a.w; w[k][4] = bq.x; w[k][5] = bq.y; w[k][6] = bq.z; w[k][7] = bq.w; }
    { const f32x4 a = *(const f32x4*)(P.cng + ch0), bq = *(const f32x4*)(P.cng + ch0 + 4); gn[0] = a.x; gn[1] = a.y; gn[2] = a.z; gn[3] = a.w; gn[4] = bq.x; gn[5] = bq.y; gn[6] = bq.z; gn[7] = bq.w; }
    float u1[8], u2[8];
#pragma unroll
    for (int k = 0; k < 2; ++k) {
        const size_t r = row0 - 2 + k;
        const u32x4 uu = *(const u32x4*)(proj + r * LDP + COL_U + ch0);
        float* dst = (k == 0) ? u2 : u1;
        dst[0] = bf_lo(uu.x); dst[1] = bf_hi(uu.x); dst[2] = bf_lo(uu.y); dst[3] = bf_hi(uu.y); dst[4] = bf_lo(uu.z); dst[5] = bf_hi(uu.z); dst[6] = bf_lo(uu.w); dst[7] = bf_hi(uu.w);
    }
#pragma unroll 4
    for (int t = 0; t < 32; ++t) {
        const size_t r = row0 + t;
        const u32x4 uu = *(const u32x4*)(proj + r * LDP + COL_U + ch0), gb = *(const u32x4*)(proj + r * LDP + COL_GB + ch0);
        float u0[8], gbf[8], y[8];
        u0[0] = bf_lo(uu.x); u0[1] = bf_hi(uu.x); u0[2] = bf_lo(uu.y); u0[3] = bf_hi(uu.y); u0[4] = bf_lo(uu.z); u0[5] = bf_hi(uu.z); u0[6] = bf_lo(uu.w); u0[7] = bf_hi(uu.w);
        gbf[0] = bf_lo(gb.x); gbf[1] = bf_hi(gb.x); gbf[2] = bf_lo(gb.y); gbf[3] = bf_hi(gb.y); gbf[4] = bf_lo(gb.z); gbf[5] = bf_hi(gb.z); gbf[6] = bf_lo(gb.w); gbf[7] = bf_hi(gb.w);
        float ss = 0.f;
#pragma unroll
        for (int j = 0; j < 8; ++j) { y[j] = gbf[j] * (w[2][j] * u0[j] + w[1][j] * u1[j] + w[0][j] * u2[j]); ss += y[j] * y[j]; u2[j] = u1[j]; u1[j] = u0[j]; }
        ss += __shfl_xor(ss, 1); ss += __shfl_xor(ss, 2); ss += __shfl_xor(ss, 4); ss += __shfl_xor(ss, 8);
        const float rs = rsqrtf(ss * (1.f / 128.f) + EPS);
        u32x4 o; o.x = cvt_pk_bf16(y[0] * rs * gn[0], y[1] * rs * gn[1]); o.y = cvt_pk_bf16(y[2] * rs * gn[2], y[3] * rs * gn[3]);
        o.z = cvt_pk_bf16(y[4] * rs * gn[4], y[5] * rs * gn[5]); o.w = cvt_pk_bf16(y[6] * rs * gn[6], y[7] * rs * gn[7]);
        *(u32x4*)(proj + r * LDP + COL_GB + ch0) = o;
    }
}

__device__ __forceinline__ void scan_phase(const Params& P) {
    const float* dec = (const float*)(P.ws + WS_DEC); bf16_t* prev = (bf16_t*)(P.ws + WS_TAIL);
    for (int gid = blockIdx.x * 512 + threadIdx.x; gid < NBATCH * 32 * 64 * 32; gid += gridDim.x * 512) {
        const int n4 = gid & 31, p = (gid >> 5) & 63, h = (gid >> 11) & 31, b = gid >> 16;
        f32x4 st = (f32x4){0.f, 0.f, 0.f, 0.f};
        size_t idx = ((size_t)(b * 128) * 32 + h) * 8192 + p * 128 + 4 * n4;
        const float* dp = dec + (b * 128) * 32 + h;
#pragma unroll 8
        for (int c = 0; c < 128; ++c) {
            const u32x2 sw = *(const u32x2*)(prev + idx); const f32x4 sv = (f32x4){bf_lo(sw.x), bf_hi(sw.x), bf_lo(sw.y), bf_hi(sw.y)}; const float d = dp[c * 32];
            st = st * d + sv;
            *(u32x2*)(prev + idx) = (u32x2){cvt_pk_bf16(st.x, st.y), cvt_pk_bf16(st.z, st.w)};
            idx += (size_t)32 * 8192;
        }
    }
}

struct OutRaw { XRows xr; u32x4 rw[7]; bf16_t rawdt; };
__device__ __forceinline__ void ssd_out_load(const Params& P, int unit, OutRaw& r) {
    const int g = unit & 7, c = ((unit >> 3) & 127) + 1, b = unit >> 10;
    const int tid = opaque_tid();
    const bf16_t* proj = (const bf16_t*)(P.ws + WS_PROJ);
    const size_t R0 = (size_t)b * LP + (size_t)c * 128;
    r.rawdt = ssd_dt_load(proj, R0, g);
    ssd_conv_x_load(r.xr, proj, R0, c, g);
    const int c8 = tid & 15, run = tid >> 4, l0 = 4 * run;
    const bf16_t* src = proj + COL_B + 128 * g + 8 * c8;
#pragma unroll
    for (int k = 0; k < 7; ++k) r.rw[k] = *(const u32x4*)(src + (R0 + l0 - 3 + k) * LDP);
}
__device__ __forceinline__ void ssd_out_unit(const Params& P, LAS unsigned char* lds, int unit, OutRaw& raw, int next_unit) {
    const int g = unit & 7, c = ((unit >> 3) & 127) + 1, b = unit >> 10;
    const int tid = opaque_tid(), lane = tid & 63, wid = tid >> 6, fr = lane & 15, fq = lane >> 4;
    bf16_t* proj = (bf16_t*)(P.ws + WS_PROJ);
    const size_t R0 = (size_t)b * LP + (size_t)c * 128;
    const bf16_t* prevg = (const bf16_t*)(P.ws + WS_TAIL) + ((size_t)(b * 128 + (c - 1)) * 32 + 4 * g) * 8192;
    u32x4 pf[2];
#pragma unroll
    for (int i = 0; i < 2; ++i) pf[i] = *(const u32x4*)(prevg + (size_t)(tid + 512 * i) * 8);
    const bf16_t rawdt = raw.rawdt; const XRows& xr = raw.xr; const u32x4 (&rw)[7] = raw.rw;
    const int l = 16 * wid + fr;
    u32x4 crow[4][4];
#pragma unroll
    for (int ks = 0; ks < 4; ++ks)
#pragma unroll
        for (int k = 0; k < 4; ++k) crow[ks][k] = *(const u32x4*)(proj + COL_C + 128 * g + 32 * ks + 8 * fq + (R0 + l - 3 + k) * LDP);
    ssd_dt_prologue(lds, rawdt, ssd_dt_weights(P, g));
    ssd_conv_x<false>(lds, xr, ssd_conv_weights2(P, 256 * g + 2 * (tid & 127)));
    {
        const int c8 = tid & 15, run = tid >> 4, n0 = 8 * c8, bc = 2048 + 128 * g + n0, l0 = 4 * run;
        float w[4][8], bb[8];
#pragma unroll
        for (int k = 0; k < 4; ++k) { const f32x4 a = *(const f32x4*)(P.cw + k * 4096 + bc), a2 = *(const f32x4*)(P.cw + k * 4096 + bc + 4);
            w[k][0] = a.x; w[k][1] = a.y; w[k][2] = a.z; w[k][3] = a.w; w[k][4] = a2.x; w[k][5] = a2.y; w[k][6] = a2.z; w[k][7] = a2.w; }
        { const f32x4 a = *(const f32x4*)(P.cb + bc), a2 = *(const f32x4*)(P.cb + bc + 4); bb[0] = a.x; bb[1] = a.y; bb[2] = a.z; bb[3] = a.w; bb[4] = a2.x; bb[5] = a2.y; bb[6] = a2.z; bb[7] = a2.w; }
#pragma unroll
        for (int t = 0; t < 4; ++t) {
            float y[8];
#pragma unroll
            for (int j = 0; j < 8; ++j) y[j] = bb[j];
#pragma unroll
            for (int k = 0; k < 4; ++k) { const u32x4 q = rw[t + k];
                y[0] += w[k][0] * bf_lo(q.x); y[1] += w[k][1] * bf_hi(q.x); y[2] += w[k][2] * bf_lo(q.y); y[3] += w[k][3] * bf_hi(q.y);
                y[4] += w[k][4] * bf_lo(q.z); y[5] += w[k][5] * bf_hi(q.z); y[6] += w[k][6] * bf_lo(q.w); y[7] += w[k][7] * bf_hi(q.w); }
#pragma unroll
            for (int j = 0; j < 8; ++j) y[j] = silu_f(y[j]);
            u32x4 o; o.x = cvt_pk_bf16(y[0], y[1]); o.y = cvt_pk_bf16(y[2], y[3]); o.z = cvt_pk_bf16(y[4], y[5]); o.w = cvt_pk_bf16(y[6], y[7]);
            *(LAS u32x4*)(lds + L_B + (l0 + t) * LROW + n0 * 2) = o;
        }
    }
    if (next_unit >= 0) ssd_out_load(P, next_unit, raw);
    bf16x8 Cf[4];
#pragma unroll
    for (int ks = 0; ks < 4; ++ks) {
        const int n0 = 32 * ks + 8 * fq, cc = 3072 + 128 * g + n0;
        float y[8];
        { const f32x4 a = *(const f32x4*)(P.cb + cc), a2 = *(const f32x4*)(P.cb + cc + 4); y[0] = a.x; y[1] = a.y; y[2] = a.z; y[3] = a.w; y[4] = a2.x; y[5] = a2.y; y[6] = a2.z; y[7] = a2.w; }
#pragma unroll
        for (int k = 0; k < 4; ++k) {
            const u32x4 q = crow[ks][k];
            const f32x4 a = *(const f32x4*)(P.cw + k * 4096 + cc), a2 = *(const f32x4*)(P.cw + k * 4096 + cc + 4);
            y[0] += a.x * bf_lo(q.x); y[1] += a.y * bf_hi(q.x); y[2] += a.z * bf_lo(q.y); y[3] += a.w * bf_hi(q.y);
            y[4] += a2.x * bf_lo(q.z); y[5] += a2.y * bf_hi(q.z); y[6] += a2.z * bf_lo(q.w); y[7] += a2.w * bf_hi(q.w);
        }
#pragma unroll
        for (int j = 0; j < 8; ++j) y[j] = silu_f(y[j]);
        u32x4 o; o.x = cvt_pk_bf16(y[0], y[1]); o.y = cvt_pk_bf16(y[2], y[3]); o.z = cvt_pk_bf16(y[4], y[5]); o.w = cvt_pk_bf16(y[6], y[7]);
        Cf[ks] = __builtin_bit_cast(bf16x8, o);
        asm volatile("" ::: "memory");
    }
#pragma unroll
    for (int i = 0; i < 2; ++i) { const int e = tid + 512 * i; *(LAS u32x4*)(lds + L_P0 + (e >> 4) * LROW + (e & 15) * 16) = pf[i]; }
    __syncthreads();
    f32x4 cbt[8];
    const int wu = __builtin_amdgcn_readfirstlane(wid);
#pragma unroll
    for (int T = 0; T < 8; ++T) { cbt[T] = (f32x4){0.f, 0.f, 0.f, 0.f};
        if (T <= wu)
#pragma unroll
        for (int ks = 0; ks < 4; ++ks) { const bf16x8 af = *(const LAS bf16x8*)(lds + L_B + (16 * T + fr) * LROW + (32 * ks + 8 * fq) * 2);
            cbt[T] = __builtin_amdgcn_mfma_f32_16x16x32_bf16(af, Cf[ks], cbt[T], 0, 0, 0); } }
    u32x2 yr0[4], yr1[4], yr2[4], yr3[4]; float ssq = 0.f;
#pragma unroll
    for (int pt = 0; pt < 4; ++pt) { yr0[pt] = yr1[pt] = yr2[pt] = yr3[pt] = (u32x2){0u, 0u}; }
#pragma unroll 1
    for (int hh = 0; hh < 4; ++hh) {
        if (hh < 3) {
#pragma unroll
            for (int i = 0; i < 2; ++i) pf[i] = *(const u32x4*)(prevg + (size_t)(hh + 1) * 8192 + (size_t)(tid + 512 * i) * 8);
        }
        const LAS float* cs = (const LAS float*)(lds + L_CS) + hh * 128; const LAS float* dt = (const LAS float*)(lds + L_DT) + hh * 128;
        const float csl = cs[l], Dh = P.dsk[4 * g + hh];
        f32x4 yd[4], yo[4];
#pragma unroll
        for (int pt = 0; pt < 4; ++pt) { yd[pt] = (f32x4){0.f, 0.f, 0.f, 0.f}; yo[pt] = (f32x4){0.f, 0.f, 0.f, 0.f}; }
#pragma unroll
        for (int q = 0; q < 4; ++q) if (2 * q <= wu) {
            float pv[8];
#pragma unroll
            for (int hf = 0; hf < 2; ++hf) {
                const int T = 2 * q + hf, s0 = 16 * T + 4 * fq;
                const f32x4 c4 = *(const LAS f32x4*)(cs + s0), d4 = *(const LAS f32x4*)(dt + s0);
#pragma unroll
                for (int r = 0; r < 4; ++r) {
                    const int s = s0 + r;
                    const float e = (s <= l) ? __expf(fminf(csl - c4[r], 0.f)) * d4[r] : 0.f;
                    float v = cbt[T][r] * e; if (s == l) v += Dh;
                    pv[hf * 4 + r] = v;
                }
            }
            u32x4 o; o.x = cvt_pk_bf16(pv[0], pv[1]); o.y = cvt_pk_bf16(pv[2], pv[3]); o.z = cvt_pk_bf16(pv[4], pv[5]); o.w = cvt_pk_bf16(pv[6], pv[7]);
            const bf16x8 pfr = __builtin_bit_cast(bf16x8, o);
#pragma unroll
            for (int pt = 0; pt < 4; ++pt) {
                const LAS unsigned char* xr = lds + L_X + (64 * hh + 16 * pt + fr) * LROW + (32 * q + 4 * fq) * 2;
                const u32x2 lo = *(const LAS u32x2*)xr, hi = *(const LAS u32x2*)(xr + 32);
                const u32x4 xx = (u32x4){lo.x, lo.y, hi.x, hi.y};
                yd[pt] = __builtin_amdgcn_mfma_f32_16x16x32_bf16(__builtin_bit_cast(bf16x8, xx), pfr, yd[pt], 0, 0, 0);
            }
        }
        const int pbuf = (hh & 1) ? L_P1 : L_P0;
#pragma unroll
        for (int ks = 0; ks < 4; ++ks)
#pragma unroll
            for (int pt = 0; pt < 4; ++pt) { const bf16x8 pa = *(const LAS bf16x8*)(lds + pbuf + (16 * pt + fr) * LROW + (32 * ks + 8 * fq) * 2);
                yo[pt] = __builtin_amdgcn_mfma_f32_16x16x32_bf16(pa, Cf[ks], yo[pt], 0, 0, 0); }
        const float el = __expf(csl);
#pragma unroll
        for (int pt = 0; pt < 4; ++pt) {
            const f32x4 v = yd[pt] + yo[pt] * el;
            yr3[pt] = yr2[pt]; yr2[pt] = yr1[pt]; yr1[pt] = yr0[pt]; yr0[pt] = (u32x2){cvt_pk_bf16(v.x, v.y), cvt_pk_bf16(v.z, v.w)};
        }
        if (hh < 3) {
            const int nbuf = (hh & 1) ? L_P0 : L_P1;
#pragma unroll
            for (int i = 0; i < 2; ++i) { const int e = tid + 512 * i; *(LAS u32x4*)(lds + nbuf + (e >> 4) * LROW + (e & 15) * 16) = pf[i]; }
        }
        __syncthreads();
    }
    (void)ssq;
    {
        constexpr int YP = 528;
        LAS unsigned char* stg = lds + L_X + wid * (16 * YP);
#pragma unroll
        for (int hh = 0; hh < 4; ++hh)
#pragma unroll
            for (int pt = 0; pt < 4; ++pt) {
                const u32x2 vp = (hh == 0) ? yr3[pt] : (hh == 1) ? yr2[pt] : (hh == 2) ? yr1[pt] : yr0[pt];
                *(LAS u32x2*)(stg + fr * YP + (64 * hh + 16 * pt + 4 * fq) * 2) = vp;
            }
        const int rsub = lane >> 5, c8 = (lane & 31) * 8;
        const f32x4 ga = *(const f32x4*)(P.sng + 256 * g + c8), gb = *(const f32x4*)(P.sng + 256 * g + c8 + 4);
        u32x4 zr[8];
#pragma unroll
        for (int j = 0; j < 8; ++j) zr[j] = *(const u32x4*)(proj + (R0 + 16 * wid + 2 * j + rsub) * LDP + COL_Z + 256 * g + c8);
#pragma unroll
        for (int j = 0; j < 8; ++j) {
            const u32x4 yv = *(const LAS u32x4*)(stg + (2 * j + rsub) * YP + c8 * 2);
            float v[8];
            v[0] = bf_lo(yv.x) * silu_f(bf_lo(zr[j].x)); v[1] = bf_hi(yv.x) * silu_f(bf_hi(zr[j].x)); v[2] = bf_lo(yv.y) * silu_f(bf_lo(zr[j].y)); v[3] = bf_hi(yv.y) * silu_f(bf_hi(zr[j].y));
            v[4] = bf_lo(yv.z) * silu_f(bf_lo(zr[j].z)); v[5] = bf_hi(yv.z) * silu_f(bf_hi(zr[j].z)); v[6] = bf_lo(yv.w) * silu_f(bf_lo(zr[j].w)); v[7] = bf_hi(yv.w) * silu_f(bf_hi(zr[j].w));
            float ss = ((v[0] * v[0] + v[1] * v[1]) + (v[2] * v[2] + v[3] * v[3])) + ((v[4] * v[4] + v[5] * v[5]) + (v[6] * v[6] + v[7] * v[7]));
            ss += __shfl_xor(ss, 1); ss += __shfl_xor(ss, 2); ss += __shfl_xor(ss, 4); ss += __shfl_xor(ss, 8); ss += __shfl_xor(ss, 16);
            const float rs = rsqrtf(ss * (1.f / 256.f) + EPS);
            u32x4 o; o.x = cvt_pk_bf16(v[0] * rs * ga.x, v[1] * rs * ga.y); o.y = cvt_pk_bf16(v[2] * rs * ga.z, v[3] * rs * ga.w);
            o.z = cvt_pk_bf16(v[4] * rs * gb.x, v[5] * rs * gb.y); o.w = cvt_pk_bf16(v[6] * rs * gb.z, v[7] * rs * gb.w);
            *(u32x4*)(proj + (R0 + 16 * wid + 2 * j + rsub) * LDP + COL_Z + 256 * g + c8) = o;
        }
    }
}

__device__ __forceinline__ void post_mix_phase(const Params& P) {
    const int lane = threadIdx.x & 63, gw = blockIdx.x * 8 + (threadIdx.x >> 6), NGW = gridDim.x * 8;
    const bf16_t* MIX = (const bf16_t*)(P.ws + WS_TAIL); bf16_t* H1N = (bf16_t*)P.out;
    for (int r = gw; r < MR; r += NGW) {
        const f32x4* xr = (const f32x4*)(P.x + (size_t)r * DM) + lane; const u32x2* mb = (const u32x2*)(MIX + (size_t)r * DM) + lane;
        const f32x4* g1 = (const f32x4*)P.g_postmix + lane; const f32x4* g2 = (const f32x4*)P.g_premlp + lane;
        f32x4 v[8]; float s = 0.f;
#pragma unroll
        for (int j = 0; j < 8; ++j) { const u32x2 w = mb[64 * j]; v[j] = (f32x4){bf_lo(w.x), bf_hi(w.x), bf_lo(w.y), bf_hi(w.y)}; s += (v[j].x * v[j].x + v[j].y * v[j].y) + (v[j].z * v[j].z + v[j].w * v[j].w); }
        const float rs = rsqrtf(wave_sum(s) * (1.f / DM) + EPS);
        float s2 = 0.f;
#pragma unroll
        for (int j = 0; j < 8; ++j) { const f32x4 xx = __builtin_nontemporal_load(xr + 64 * j), gg = g1[64 * j]; v[j] = xx + v[j] * rs * gg; s2 += (v[j].x * v[j].x + v[j].y * v[j].y) + (v[j].z * v[j].z + v[j].w * v[j].w); }
        const float rs2 = rsqrtf(wave_sum(s2) * (1.f / DM) + EPS);
        u32x2* o8 = (u32x2*)(H1N + (size_t)r * DM) + lane;
#pragma unroll
        for (int j = 0; j < 8; ++j) { const f32x4 gg = g2[64 * j]; o8[64 * j] = (u32x2){cvt_pk_bf16(v[j].x * rs2 * gg.x, v[j].y * rs2 * gg.y), cvt_pk_bf16(v[j].z * rs2 * gg.z, v[j].w * rs2 * gg.w)}; }
    }
}
__device__ __forceinline__ void final_phase(const Params& P) {
    const int lane = threadIdx.x & 63, gw = blockIdx.x * 8 + (threadIdx.x >> 6), NGW = gridDim.x * 8;
    const bf16_t* FF = (const bf16_t*)(P.ws + WS_FF); const bf16_t* MIX = (const bf16_t*)(P.ws + WS_TAIL);
    for (int r = gw; r < MR; r += NGW) {
        f32x4* orow = (f32x4*)(P.out + (size_t)r * DM) + lane; const f32x4* xr = (const f32x4*)(P.x + (size_t)r * DM) + lane;
        const u32x2* fb = (const u32x2*)(FF + (size_t)r * DM) + lane; const u32x2* mb = (const u32x2*)(MIX + (size_t)r * DM) + lane;
        const f32x4* g1 = (const f32x4*)P.g_postmix + lane; const f32x4* g2 = (const f32x4*)P.g_postmlp + lane;
        f32x4 v[8], m[8]; float s = 0.f, sm = 0.f;
#pragma unroll
        for (int j = 0; j < 8; ++j) { const u32x2 w = __builtin_nontemporal_load(fb + 64 * j); v[j] = (f32x4){bf_lo(w.x), bf_hi(w.x), bf_lo(w.y), bf_hi(w.y)}; s += (v[j].x * v[j].x + v[j].y * v[j].y) + (v[j].z * v[j].z + v[j].w * v[j].w);
            const u32x2 q = __builtin_nontemporal_load(mb + 64 * j); m[j] = (f32x4){bf_lo(q.x), bf_hi(q.x), bf_lo(q.y), bf_hi(q.y)}; sm += (m[j].x * m[j].x + m[j].y * m[j].y) + (m[j].z * m[j].z + m[j].w * m[j].w); }
        const float rs = rsqrtf(wave_sum(s) * (1.f / DM) + EPS), rsm = rsqrtf(wave_sum(sm) * (1.f / DM) + EPS);
#pragma unroll
        for (int j = 0; j < 8; ++j) { const f32x4 xx = __builtin_nontemporal_load(xr + 64 * j), ga = g1[64 * j], gb = g2[64 * j]; __builtin_nontemporal_store((xx + m[j] * rsm * ga) + v[j] * rs * gb, orow + 64 * j); }
    }
}

#define XB_TMO      128
#define XB_XCNT(j)  (256  + 64 * (j))
#define XB_XSUB(j)  (1280 + 64 * (j))
#define XB_XGEN(j)  (2304 + 64 * (j))
#define XB_TOP      3328
#define XB_TOPGEN   3392
#define XCD_BAR_WORDS 3456
#define XB_SPIN_CAP (1u << 18)
__device__ __forceinline__ unsigned xb_ld(unsigned* p)              { return __hip_atomic_load(p, __ATOMIC_RELAXED, __HIP_MEMORY_SCOPE_AGENT); }
__device__ __forceinline__ unsigned xb_add(unsigned* p, unsigned v) { return __hip_atomic_fetch_add(p, v, __ATOMIC_RELAXED, __HIP_MEMORY_SCOPE_AGENT); }
__device__ __forceinline__ unsigned xb_xcc_id() { return (unsigned)__builtin_amdgcn_s_getreg((3 << 11) | 20) & 0xFu; }
#define XB_SPIN(cond, bar) do { unsigned _sp = 0; while (cond) { __builtin_amdgcn_s_sleep(1); \
    if ((++_sp & 255u) == 0u) { if (xb_ld(&(bar)[XB_TMO])) break; if (_sp > XB_SPIN_CAP) { atomicAdd(&(bar)[XB_TMO], 1u); break; } } } } while (0)
struct XcdBarrier { unsigned* bar; unsigned x; volatile LAS unsigned* st; };
__device__ __forceinline__ XcdBarrier xcd_barrier_post(unsigned* bar, volatile LAS unsigned* st) {
    XcdBarrier b; b.bar = bar; b.x = xb_xcc_id(); b.st = st;
    if (threadIdx.x == 0) (void)xb_add(&bar[XB_XCNT(b.x)], 1u);
    return b;
}
__device__ __forceinline__ void xcd_barrier_complete(unsigned* bar, unsigned x, unsigned& nloc, unsigned& nx) {
    const unsigned G = gridDim.x * gridDim.y * gridDim.z;
    unsigned sum, cnt, mine, sp = 0u;
    for (;;) {
        sum = 0u; cnt = 0u; mine = 0u;
#pragma unroll
        for (unsigned j = 0; j < 16; ++j) { const unsigned c = xb_ld(&bar[XB_XCNT(j)]); sum += c; cnt += (c > 0u) ? 1u : 0u; mine = (j == x) ? c : mine; }
        if (sum == G) break;
        __builtin_amdgcn_s_sleep(1);
        if ((++sp & 255u) == 0u) { if (xb_ld(&bar[XB_TMO])) break; if (sp > XB_SPIN_CAP) { atomicAdd(&bar[XB_TMO], 1u); break; } }
    }
    nloc = mine > 0u ? mine : 1u; nx = cnt > 0u ? cnt : 1u;
}
__device__ __forceinline__ void xcd_barrier(const XcdBarrier& b) {
    asm volatile("s_waitcnt vmcnt(0)" ::: "memory");
    __syncthreads();
    if (threadIdx.x == 0) {
        unsigned* bar = b.bar;
        __builtin_amdgcn_s_waitcnt(0);
        unsigned nloc = b.st[0], nx = b.st[1];
        if (nloc == 0u) { xcd_barrier_complete(bar, b.x, nloc, nx); b.st[0] = nloc; b.st[1] = nx; }
        const unsigned old = xb_add(&bar[XB_XSUB(b.x)], 1u);
        const unsigned gen = old / nloc;
        if (old + 1u == (gen + 1u) * nloc) {
            __builtin_amdgcn_fence(__ATOMIC_RELEASE, "agent");
            asm volatile("s_waitcnt vmcnt(0)" ::: "memory");
            const unsigned og = xb_add(&bar[XB_TOP], 1u);
            const unsigned tg = og / nx;
            if (og + 1u == (tg + 1u) * nx) xb_add(&bar[XB_TOPGEN], 1u);
            else XB_SPIN(xb_ld(&bar[XB_TOPGEN]) == tg, bar);
            __builtin_amdgcn_fence(__ATOMIC_ACQUIRE, "agent");
            xb_add(&bar[XB_XGEN(b.x)], 1u);
            asm volatile("s_waitcnt vmcnt(0)" ::: "memory");
        } else {
            XB_SPIN(xb_ld(&bar[XB_XGEN(b.x)]) == gen, bar);
            __builtin_amdgcn_fence(__ATOMIC_ACQUIRE, "agent");
            asm volatile("s_waitcnt vmcnt(0)" ::: "memory");
        }
    }
    __syncthreads();
}

extern __shared__ __attribute__((aligned(16))) unsigned char dyn_lds[];

__global__ void __launch_bounds__(512) hymba_fwd(Params P) {
    cg::grid_group grid = cg::this_grid();
    LAS unsigned char* lds = (LAS unsigned char*)dyn_lds;
    const int G = gridDim.x;
    pg8::StaticOrder S;
    LAS unsigned char* epi_stg = lds + 131072 + (threadIdx.x >> 6) * pg8::EPI_STG_BYTES;
    volatile LAS unsigned* xst = (volatile LAS unsigned*)(lds + LDS_MAIN);
    unsigned* xbar = (unsigned*)(P.ws + WS_BAR);
    if (threadIdx.x == 0) { xst[0] = 0u; xst[1] = 0u; }
    if (blockIdx.x == 0) for (int i = threadIdx.x; i < XCD_BAR_WORDS; i += 512) xbar[i] = 0u;
#ifndef SKIP_P0
    phase0(P, lds);
#endif
#if defined(PROBE_X2) && (PROBE_X2 & 1)
    __syncthreads(); phase0(P, lds);
#endif
    grid.sync();
    const XcdBarrier xb = xcd_barrier_post(xbar, xst);
    { pg8::Gemm gm{(const bf16_t*)P.out, (const bf16_t*)(P.ws + WS_TAIL), TP / 256, NPAD / 256, DM, DM, 0};
      S.init(gm.nM, gm.nN, G, blockIdx.x);
      pg8::EpiInProj E{(bf16_t*)(P.ws + WS_PROJ), epi_stg};
#ifndef SKIP_GEMM
      pg8::gemm_phase(lds, gm, S, E);
#endif
#if defined(PROBE_GEMM2) && (PROBE_GEMM2 & 1)
      __syncthreads();
#ifdef PROBE_SAMETILE
      S.same = true;
#endif
      pg8::gemm_phase<decltype(E), PROBE_NOEPI>(lds, gm, S, E); S.same = false;
#endif
    }
    xcd_barrier(xb);
#ifndef SKIP_P2
    {
        constexpr int NU = NBATCH * 128 * 8;
        int u = blockIdx.x;
        if (u < NU) {
            StatesRaw ra; ssd_states_load(P, u, ra);
            for (; u < NU; u += G) { const int g = u & 7, t_ = opaque_tid();
                StatesW W; W.xw = ssd_conv_weights2(P, 256 * g + 2 * (t_ & 127)); W.bw = ssd_conv_weights2(P, 2048 + 128 * g + 2 * (t_ & 63)); W.dw = ssd_dt_weights(P, g);
                ssd_states_unit(P, lds, u, ra, W, (u + G < NU) ? u + G : -1); }
        }
    }
#endif
#if defined(PROBE_X2) && (PROBE_X2 & 2)
    ;
#endif
#ifndef SKIP_SC
    for (int t = blockIdx.x * 8 + (threadIdx.x >> 6); t < (MR / 32) * 4; t += G * 8) shortconv_task(P, t, threadIdx.x & 63);
#endif
    xcd_barrier(xb);
#ifndef SKIP_P3
    scan_phase(P);
#endif
#if defined(PROBE_X2) && (PROBE_X2 & 4)
    scan_phase(P);
#endif
    xcd_barrier(xb);
#ifndef SKIP_P4
    {   constexpr int NU = NBATCH * 128 * 8; OutRaw raw; int u = blockIdx.x;
        if (u < NU) ssd_out_load(P, u, raw);
        for (; u < NU; u += G) ssd_out_unit(P, lds, u, raw, (u + G < NU) ? u + G : -1); }
#endif
    xcd_barrier(xb);
    { pg8::Gemm gm{(const bf16_t*)(P.ws + WS_PROJ), (const bf16_t*)(P.ws + WS_WOUT), MR / 256, DM / 256, DMIX, LDP, 1};
      S.init(gm.nM, gm.nN, G, blockIdx.x);
      pg8::EpiBf16<0> E{(bf16_t*)(P.ws + WS_TAIL), DM, epi_stg};
#ifndef SKIP_GEMM
      pg8::gemm_phase(lds, gm, S, E);
#endif
#if defined(PROBE_GEMM2) && (PROBE_GEMM2 & 2)
      __syncthreads();
#ifdef PROBE_SAMETILE
      S.same = true;
#endif
      pg8::gemm_phase<decltype(E), PROBE_NOEPI>(lds, gm, S, E); S.same = false;
#endif
    }
    xcd_barrier(xb);
#ifndef SKIP_P6
    post_mix_phase(P);
#endif
    xcd_barrier(xb);
    { pg8::Gemm gm{(const bf16_t*)P.out, (const bf16_t*)(P.ws + WS_W1), MR / 256, DFF / 256, DM, DM, 0};
      S.init(gm.nM, gm.nN, G, blockIdx.x);
      pg8::EpiBf16<1> E{(bf16_t*)(P.ws + WS_HID), DFF, epi_stg};
#ifndef SKIP_GEMM
      pg8::gemm_phase(lds, gm, S, E);
#endif
#if defined(PROBE_GEMM2) && (PROBE_GEMM2 & 4)
      __syncthreads();
#ifdef PROBE_SAMETILE
      S.same = true;
#endif
      pg8::gemm_phase<decltype(E), PROBE_NOEPI>(lds, gm, S, E); S.same = false;
#endif
    }
    xcd_barrier(xb);
    { pg8::Gemm gm{(const bf16_t*)(P.ws + WS_HID), (const bf16_t*)(P.ws + WS_W2), MR / 256, DM / 256, DFF, DFF, 0};
      S.init(gm.nM, gm.nN, G, blockIdx.x);
      pg8::EpiBf16<0> E{(bf16_t*)(P.ws + WS_FF), DM, epi_stg};
#ifndef SKIP_GEMM
      pg8::gemm_phase(lds, gm, S, E);
#endif
#if defined(PROBE_GEMM2) && (PROBE_GEMM2 & 8)
      __syncthreads();
#ifdef PROBE_SAMETILE
      S.same = true;
#endif
      pg8::gemm_phase<decltype(E), PROBE_NOEPI>(lds, gm, S, E); S.same = false;
#endif
    }
    xcd_barrier(xb);
#ifndef SKIP_P9
    final_phase(P);
#endif
}

extern "C" void kernel_launch(void* const* d_in, const int* in_sizes, int n_in, void* d_out, int out_size, void* d_ws, size_t ws_size, hipStream_t stream) {
    static int grid = 0;
    if (!grid) {
        if (n_in != 18 || ws_size < WS_END) { fprintf(stderr, "kernel_launch: unexpected n_in %d / ws %zu (need %zu)\n", n_in, ws_size, (size_t)WS_END); grid = -1; return; }
        int dev = 0, cus = 0, per_cu = 0;
        (void)hipGetDevice(&dev);
        (void)hipDeviceGetAttribute(&cus, hipDeviceAttributeMultiprocessorCount, dev);
        (void)hipFuncSetAttribute((const void*)hymba_fwd, hipFuncAttributeMaxDynamicSharedMemorySize, LDS_BYTES);
        (void)hipOccupancyMaxActiveBlocksPerMultiprocessor(&per_cu, (const void*)hymba_fwd, 512, LDS_BYTES);
        if (per_cu < 1) { fprintf(stderr, "kernel_launch: occupancy query says %d blocks per CU\n", per_cu); per_cu = 1; }
        grid = cus;
    }
    if (grid < 0) return;
    Params p{};
    const float** f = (const float**)&p;
    for (int i = 0; i < 18; ++i) f[i] = (const float*)d_in[i];
    p.out = (float*)d_out; p.ws = (unsigned char*)d_ws;
    void* args[] = {&p};
    hipError_t e = hipLaunchCooperativeKernel((const void*)hymba_fwd, dim3(grid), dim3(512), args, LDS_BYTES, stream);
    if (e != hipSuccess) fprintf(stderr, "cooperative launch failed: %s (grid %d)\n", hipGetErrorString(e), grid);
}
```
